# Optimizing an MI355X kernel written in HIP

```python
import math
import jax, jax.numpy as jnp
from jax import lax
import numpy as np

D_MODEL = 1024
BATCH = 16
SEQ = 2048
DEPTH = 4

CHUNK = 64
N_META = 16
D_MIX = D_MODEL
SB_HEAD_DIM = 64
SB_WIDTH = D_MIX // 2
SB_HEADS = SB_WIDTH // SB_HEAD_DIM
CONF_WIDTH = D_MIX // 4
CONF_KERNEL = 31
SC_WIDTH = D_MIX - SB_WIDTH - CONF_WIDTH
SC_KERNEL = 3
D_IN = 3 * SB_WIDTH + 2 * CONF_WIDTH + 3 * SC_WIDTH
D_FF = 4 * D_MODEL
QBLOCK = 128
DEEPNORM_ALPHA = (2.0 * DEPTH) ** 0.25
DEEPNORM_BETA = (8.0 * DEPTH) ** -0.25
LN_EPS = 1e-5
RMS_EPS = 1e-6

kernel_name = "hymba_stickbreak_conformer_shortconv_deepnorm"


def layer_norm(x, g, b):
    xf = x.astype(jnp.float32)
    mu = jnp.mean(xf, axis=-1, keepdims=True)
    var = jnp.mean(jnp.square(xf - mu), axis=-1, keepdims=True)
    out = (xf - mu) * lax.rsqrt(var + LN_EPS) * g.astype(jnp.float32) + b.astype(jnp.float32)
    return out.astype(x.dtype)


def rms_norm(x, g):
    xf = x.astype(jnp.float32)
    out = xf * lax.rsqrt(jnp.mean(jnp.square(xf), axis=-1, keepdims=True) + RMS_EPS) * g.astype(jnp.float32)
    return out.astype(x.dtype)


def causal_depthwise_conv(x, w):
    k_width, ch = w.shape
    return lax.conv_general_dilated(
        x, w[:, None, :].astype(x.dtype), window_strides=(1,), padding=[(k_width - 1, 0)],
        dimension_numbers=("NWC", "WIO", "NWC"), feature_group_count=ch)


def stick_breaking_attention(q, k, v):
    bsz, n_heads, length, dh = q.shape
    n_blk = -(-length // QBLOCK)
    pad = ((0, 0), (0, 0), (0, n_blk * QBLOCK - length), (0, 0))
    q, k, v = jnp.pad(q, pad), jnp.pad(k, pad), jnp.pad(v, pad)
    scale = dh ** -0.5
    outs = []
    for i in range(n_blk):
        q0, kend = i * QBLOCK, (i + 1) * QBLOCK
        qb = q[:, :, q0:kend].astype(jnp.float32)
        kb = k[:, :, :kend].astype(jnp.float32)
        vb = v[:, :, :kend].astype(jnp.float32)
        z = jnp.einsum("bhtd,bhsd->bhts", qb, kb) * scale
        t_idx = q0 + jnp.arange(QBLOCK)[:, None]
        s_idx = jnp.arange(kend)[None, :]
        past = s_idx < t_idx
        log_keep = jnp.where(past, -jax.nn.softplus(z), 0.0)
        between = lax.cumsum(log_keep, axis=3, reverse=True) - log_keep
        log_a = jax.nn.log_sigmoid(z) + between
        a = jnp.where(past, jnp.exp(log_a), 0.0)
        outs.append(jnp.einsum("bhts,bhsd->bhtd", a, vb))
    o = jnp.concatenate(outs, axis=2)[:, :, :length]
    return o.astype(v.dtype)


def conformer_conv(u, w_dw, b_dw, ln_g, ln_b):
    a, gate = jnp.split(u, 2, axis=-1)
    h = a * jax.nn.sigmoid(gate)
    h = causal_depthwise_conv(h, w_dw) + b_dw.astype(h.dtype)
    h = layer_norm(h, ln_g, ln_b)
    return jax.nn.swish(h)


def short_gated_conv(u, w_dw):
    b_gate, c_gate, h = jnp.split(u, 3, axis=-1)
    return b_gate * causal_depthwise_conv(c_gate * h, w_dw)


def hybrid_mixer(h, w_in, w_conf_dw, b_conf_dw, ln_conf_g, ln_conf_b, w_short_dw, g_mix, w_out):
    bsz, length, _ = h.shape
    u = h @ w_in
    q, k, v, conf_in, sc_in = jnp.split(
        u, [SB_WIDTH, 2 * SB_WIDTH, 3 * SB_WIDTH, 3 * SB_WIDTH + 2 * CONF_WIDTH], axis=-1)

    def to_heads(t):
        return t.reshape(bsz, length, SB_HEADS, SB_HEAD_DIM).transpose(0, 2, 1, 3)

    o_sb = stick_breaking_attention(to_heads(q), to_heads(k), to_heads(v))
    o_sb = o_sb.transpose(0, 2, 1, 3).reshape(bsz, length, SB_WIDTH)
    o_conf = conformer_conv(conf_in, w_conf_dw, b_conf_dw, ln_conf_g, ln_conf_b)
    o_sc = short_gated_conv(sc_in, w_short_dw)
    g_sb, g_conf, g_sc = jnp.split(g_mix, [SB_WIDTH, SB_WIDTH + CONF_WIDTH])
    y = jnp.concatenate([rms_norm(o_sb, g_sb), rms_norm(o_conf, g_conf), rms_norm(o_sc, g_sc)], axis=-1)
    return y @ w_out


def squared_relu_mlp(h, w1, w2):
    return jnp.square(jax.nn.relu(h @ w1)) @ w2


def setup_inputs(seed: int = 0) -> dict:
    key = jax.random.key(seed)
    ks = jax.random.split(key, 20)
    f32 = jnp.float32

    def nrm(k, shape, scale):
        return jax.random.normal(k, shape, f32) * scale

    return {
        "x": nrm(ks[0], (BATCH, SEQ, D_MODEL), 1.0),
        "meta_tokens": nrm(ks[1], (N_META, D_MODEL), 1.0),
        "ln_in_g": 1.0 + nrm(ks[2], (D_MODEL,), 0.01),
        "ln_in_b": nrm(ks[3], (D_MODEL,), 0.01),
        "w_in": nrm(ks[4], (DEPTH, D_MODEL, D_IN), D_MODEL ** -0.5),
        "w_conf_dw": nrm(ks[5], (DEPTH, CONF_KERNEL, CONF_WIDTH), CONF_KERNEL ** -0.5),
        "b_conf_dw": nrm(ks[6], (DEPTH, CONF_WIDTH), 0.01),
        "ln_conf_g": 1.0 + nrm(ks[7], (DEPTH, CONF_WIDTH), 0.01),
        "ln_conf_b": nrm(ks[8], (DEPTH, CONF_WIDTH), 0.01),
        "w_short_dw": nrm(ks[9], (DEPTH, SC_KERNEL, SC_WIDTH), SC_KERNEL ** -0.5),
        "g_mix": 1.0 + nrm(ks[10], (DEPTH, D_MIX), 0.01),
        "w_out": nrm(ks[11], (DEPTH, D_MIX, D_MODEL), D_MIX ** -0.5 * DEEPNORM_BETA),
        "ln_mix_g": 1.0 + nrm(ks[12], (DEPTH, D_MODEL), 0.01),
        "ln_mix_b": nrm(ks[13], (DEPTH, D_MODEL), 0.01),
        "w_ff1": nrm(ks[14], (DEPTH, D_MODEL, D_FF), D_MODEL ** -0.5),
        "w_ff2": nrm(ks[15], (DEPTH, D_FF, D_MODEL), D_FF ** -0.5 * DEEPNORM_BETA),
        "ln_ff_g": 1.0 + nrm(ks[16], (DEPTH, D_MODEL), 0.01),
        "ln_ff_b": nrm(ks[17], (DEPTH, D_MODEL), 0.01),
    }


def reference(x, meta_tokens, ln_in_g, ln_in_b, w_in, w_conf_dw, b_conf_dw, ln_conf_g, ln_conf_b,
              w_short_dw, g_mix, w_out, ln_mix_g, ln_mix_b, w_ff1, w_ff2, ln_ff_g, ln_ff_b):
    bsz = x.shape[0]
    meta = jnp.broadcast_to(meta_tokens[None].astype(x.dtype), (bsz, N_META, D_MODEL))
    h = layer_norm(jnp.concatenate([meta, x], axis=1), ln_in_g, ln_in_b)
    for l in range(DEPTH):
        mix = hybrid_mixer(h, w_in[l], w_conf_dw[l], b_conf_dw[l], ln_conf_g[l], ln_conf_b[l],
                           w_short_dw[l], g_mix[l], w_out[l])
        h = layer_norm(DEEPNORM_ALPHA * h + mix, ln_mix_g[l], ln_mix_b[l])
        ff = squared_relu_mlp(h, w_ff1[l], w_ff2[l])
        h = layer_norm(DEEPNORM_ALPHA * h + ff, ln_ff_g[l], ln_ff_b[l])
    return h[:, N_META:]
```

```cpp
#include <hip/hip_runtime.h>
#include <hip/hip_cooperative_groups.h>
#include <cstdint>
#include <cstdio>
namespace cg = cooperative_groups;

#ifndef ONE_LAUNCH
#define ONE_LAUNCH 1
#endif

#define DEV __device__ __forceinline__
__device__ __forceinline__ int tid_() { int t = threadIdx.x; asm volatile("" : "+v"(t)); return t; }
typedef unsigned short bf16_t;
typedef short bf16x8 __attribute__((ext_vector_type(8)));
typedef float f32x4 __attribute__((ext_vector_type(4)));
typedef float f32x16 __attribute__((ext_vector_type(16)));

constexpr int D = 1024, NB = 16, SEQ = 2048, NMETA = 16;
constexpr int MX = NB * SEQ;
constexpr int MTOT = MX + NB * NMETA;
constexpr int DIN = 2816, DFF = 4096, DEPTH = 4;
constexpr float ALPHA = 1.681792830507429f;
constexpr float QSCALE = 0.125f * 1.4426950408889634f;
constexpr int NTHREADS = 512;
constexpr int LDS_BYTES = 131072;

struct Params {
    const float *x, *meta, *ln_in_g, *ln_in_b, *w_in, *w_conf_dw, *b_conf_dw, *ln_conf_g, *ln_conf_b, *w_short_dw, *g_mix,
        *w_out, *ln_mix_g, *ln_mix_b, *w_ff1, *w_ff2, *ln_ff_g, *ln_ff_b;
    float* out;
    bf16_t *wt_in, *wt_out, *wt_ff1, *wt_ff2, *hb, *u, *y, *hid;
    float* zmeta;
};

DEV unsigned pk_bf16(float lo, float hi) { unsigned r; asm("v_cvt_pk_bf16_f32 %0, %1, %2" : "=v"(r) : "v"(lo), "v"(hi)); return r; }
DEV float bflo(unsigned w) { return __uint_as_float(w << 16); }
DEV float bfhi(unsigned w) { return __uint_as_float(w & 0xffff0000u); }
DEV float wave_sum(float v) {
#pragma unroll
    for (int o = 32; o >= 1; o >>= 1) v += __shfl_xor(v, o);
    return v;
}
DEV float* zrow(const Params& p, int row) { return row < MX ? p.out + (size_t)row * D : p.zmeta + (size_t)(row - MX) * D; }
DEV int row_of(int b, int q) { return q < NMETA ? MX + b * NMETA + q : b * SEQ + (q - NMETA); }

DEV void transpose_unit(const float* __restrict__ W, bf16_t* __restrict__ Wt, int K, int N, int kt, int nt, float* tile) {
    const int tid = tid_();
    {
        const int kr = tid >> 3, nc = (tid & 7) * 8;
        const float* src = W + (size_t)(kt * 64 + kr) * N + nt * 64 + nc;
        const float4 a = *(const float4*)src, b = *(const float4*)(src + 4);
        float* t = tile + kr * 65 + nc;
        t[0] = a.x; t[1] = a.y; t[2] = a.z; t[3] = a.w; t[4] = b.x; t[5] = b.y; t[6] = b.z; t[7] = b.w;
    }
    __syncthreads();
    {
        const int n = tid >> 3, kc = (tid & 7) * 8;
        const float* t = tile + kc * 65 + n;
        uint4 w;
        w.x = pk_bf16(t[0], t[65]); w.y = pk_bf16(t[130], t[195]); w.z = pk_bf16(t[260], t[325]); w.w = pk_bf16(t[390], t[455]);
        *(uint4*)(Wt + (size_t)(nt * 64 + n) * K + kt * 64 + kc) = w;
    }
    __syncthreads();
}

DEV void ln_row_store(const float4 (&v)[4], const float* __restrict__ g, const float* __restrict__ b, bf16_t* dst, float* dstf, int lane) {
    float s = 0.f;
#pragma unroll
    for (int i = 0; i < 4; ++i) s += (v[i].x + v[i].y) + (v[i].z + v[i].w);
    const float mu = wave_sum(s) * (1.0f / D);
    float q = 0.f;
#pragma unroll
    for (int i = 0; i < 4; ++i) { const float a = v[i].x - mu, bb = v[i].y - mu, c = v[i].z - mu, d = v[i].w - mu; q += (a * a + bb * bb) + (c * c + d * d); }
    const float rstd = rsqrtf(wave_sum(q) * (1.0f / D) + 1e-5f);
#pragma unroll
    for (int i = 0; i < 4; ++i) {
        const int col = lane * 4 + 256 * i;
        const float4 gg = *(const float4*)(g + col), bb = *(const float4*)(b + col);
        float4 o;
        o.x = (v[i].x - mu) * rstd * gg.x + bb.x; o.y = (v[i].y - mu) * rstd * gg.y + bb.y;
        o.z = (v[i].z - mu) * rstd * gg.z + bb.z; o.w = (v[i].w - mu) * rstd * gg.w + bb.w;
        if (dst) { uint2 w; w.x = pk_bf16(o.x, o.y); w.y = pk_bf16(o.z, o.w); *(uint2*)(dst + col) = w; }
        if (dstf) *(float4*)(dstf + col) = o;
    }
}

DEV void prologue_phase(const Params& p, char* smem) {
    float* tile = (float*)smem;
    const int n_in = 16 * 44, n_out = 16 * 16, n_f1 = 16 * 64, n_f2 = 64 * 16;
    const int per_layer = n_in + n_out + n_f1 + n_f2;
    for (int u = blockIdx.x; u < per_layer * DEPTH; u += gridDim.x) {
        const int l = u / per_layer; int r = u % per_layer;
        if (r < n_in) { transpose_unit(p.w_in + (size_t)l * D * DIN, p.wt_in + (size_t)l * D * DIN, D, DIN, r / 44, r % 44, tile); continue; }
        r -= n_in;
        if (r < n_out) { transpose_unit(p.w_out + (size_t)l * D * D, p.wt_out + (size_t)l * D * D, D, D, r / 16, r % 16, tile); continue; }
        r -= n_out;
        if (r < n_f1) { transpose_unit(p.w_ff1 + (size_t)l * D * DFF, p.wt_ff1 + (size_t)l * D * DFF, D, DFF, r / 64, r % 64, tile); continue; }
        r -= n_f1;
        transpose_unit(p.w_ff2 + (size_t)l * D * DFF, p.wt_ff2 + (size_t)l * D * DFF, DFF, D, r / 16, r % 16, tile);
    }
    const int tid = tid_(), wid = tid >> 6, lane = tid & 63;
    for (int row = blockIdx.x * 8 + wid; row < MTOT; row += gridDim.x * 8) {
        const float* src = row < MX ? p.x + (size_t)row * D : p.meta + (size_t)((row - MX) & 15) * D;
        float4 v[4];
#pragma unroll
        for (int i = 0; i < 4; ++i) v[i] = *(const float4*)(src + lane * 4 + 256 * i);
        ln_row_store(v, p.ln_in_g, p.ln_in_b, p.hb + (size_t)row * D, nullptr, lane);
    }
}

DEV void ln_phase(const Params& p, const float* g, const float* b, bool final) {
    const int tid = tid_(), wid = tid >> 6, lane = tid & 63;
    for (int row = blockIdx.x * 8 + wid; row < MTOT; row += gridDim.x * 8) {
        float* src = zrow(p, row);
        float4 v[4];
#pragma unroll
        for (int i = 0; i < 4; ++i) v[i] = *(const float4*)(src + lane * 4 + 256 * i);
        if (final) { if (row < MX) ln_row_store(v, g, b, nullptr, src, lane); }
        else ln_row_store(v, g, b, p.hb + (size_t)row * D, nullptr, lane);
    }
}

#define PG8_LAS __attribute__((address_space(3)))
constexpr int BM = 256, BK = 64, HALF = 128, HTB = HALF * BK * 2, STAGE_BYTES = 8 * HTB;
DEV int lds_byte(int r, int c) { const int st = (r >> 4) * 2 + (c >> 5), rr = r & 15, cc = c & 31, ob = rr * 64 + cc * 2; return st * 1024 + (ob ^ (((ob >> 9) & 1) << 5)); }
DEV void stage_rc(int b, int& R, int& C) { const int st = b / 1024, sb = b % 1024, swz = sb ^ (((sb >> 9) & 1) << 5); R = (st >> 1) * 16 + swz / 64; C = (st & 1) * 32 + (swz % 64) / 2; }
DEV int perm32(int rho) { const int n = rho >> 4, i = rho & 15; return 8 * (i >> 2) + 4 * n + (i & 3); }
struct Unit { int pm, pn; };
struct Gemm { const bf16_t* A; const bf16_t* Bt; int M, N, K; };

struct Order {
    int nM, nN, nwg, G, c;
    DEV void init(int M, int N, int G_, int c_) { nM = M / BM; nN = N / BM; nwg = nM * nN; G = G_; c = c_; }
    DEV bool next(int i, Unit& u) const {
        const int L = i * G + c; if (L >= nwg) return false;
        const int nig = 8 * nN, gid = L / nig, fm = gid * 8, gsz = (nM - fm) < 8 ? (nM - fm) : 8;
        u.pm = fm + ((L % nig) % gsz); u.pn = (L % nig) / gsz; return true;
    }
    DEV void a_ready(const Unit&) const {}
    DEV void done(const Unit&) const {}
};

template <int MODE> struct Epi {
    static constexpr bool PERM = true, AFTER_DRAIN = false;
    bf16_t* ob;
    const bf16_t* hb;
    float* zx; float* zm;
    DEV void operator()(const f32x4 (&acc)[2][2][4][2], const Unit& u, int wr, int wc, int fr, int fq) const {
        const int row0 = u.pm * BM + wr * 64 + fr, col0 = u.pn * BM + wc * 32 + 8 * fq;
#pragma unroll
        for (int ai = 0; ai < 2; ++ai)
#pragma unroll
            for (int m = 0; m < 4; ++m) {
                const int row = row0 + ai * HALF + m * 16;
#pragma unroll
                for (int bj = 0; bj < 2; ++bj) {
                    const int col = col0 + bj * HALF;
                    f32x4 v0 = acc[ai][bj][m][0], v1 = acc[ai][bj][m][1];
                    if (MODE == 0) {
                        if (col < 512) { v0 = v0 * QSCALE; v1 = v1 * QSCALE; }
                        uint4 w; w.x = pk_bf16(v0[0], v0[1]); w.y = pk_bf16(v0[2], v0[3]); w.z = pk_bf16(v1[0], v1[1]); w.w = pk_bf16(v1[2], v1[3]);
                        *(uint4*)(ob + (size_t)row * DIN + col) = w;
                    } else if (MODE == 1) {
#pragma unroll
                        for (int k = 0; k < 4; ++k) { v0[k] = fmaxf(v0[k], 0.f); v1[k] = fmaxf(v1[k], 0.f); }
                        v0 = v0 * v0; v1 = v1 * v1;
                        uint4 w; w.x = pk_bf16(v0[0], v0[1]); w.y = pk_bf16(v0[2], v0[3]); w.z = pk_bf16(v1[0], v1[1]); w.w = pk_bf16(v1[2], v1[3]);
                        *(uint4*)(ob + (size_t)row * DFF + col) = w;
                    } else {
                        const uint4 hw = *(const uint4*)(hb + (size_t)row * D + col);
                        f32x4 o0, o1;
                        o0[0] = ALPHA * bflo(hw.x) + v0[0]; o0[1] = ALPHA * bfhi(hw.x) + v0[1]; o0[2] = ALPHA * bflo(hw.y) + v0[2]; o0[3] = ALPHA * bfhi(hw.y) + v0[3];
                        o1[0] = ALPHA * bflo(hw.z) + v1[0]; o1[1] = ALPHA * bfhi(hw.z) + v1[1]; o1[2] = ALPHA * bflo(hw.w) + v1[2]; o1[3] = ALPHA * bfhi(hw.w) + v1[3];
                        float* zr = (row < MX ? zx + (size_t)row * D : zm + (size_t)(row - MX) * D) + col;
                        *(f32x4*)zr = o0; *(f32x4*)(zr + 4) = o1;
                    }
                }
            }
    }
};

template <class Epi, class Sched, bool ALIGN_EPI = false, bool SP2 = false>
__device__ __forceinline__ void gemm_phase(PG8_LAS unsigned char* lds, const Gemm g, const Sched& S, const Epi& E) {
    const int tid = tid_(), wid = __builtin_amdgcn_readfirstlane(tid >> 6), lane = tid & 63, wr = wid >> 2, wc = wid & 3, fr = lane & 15, fq = lane >> 4;
    const int K = g.K, nt = K / BK;
    unsigned voffA[2], voffB[2];
#pragma unroll
    for (int i = 0; i < 2; ++i) { int R, C; stage_rc(tid * 16 + i * 8192, R, C); const int Rb = Epi::PERM ? ((R & ~31) + perm32(R & 31)) : R;
        voffA[i] = (unsigned)(R * K + C) * 2u; voffB[i] = (unsigned)(Rb * K + C) * 2u; }
    const size_t kstep = (size_t)(BK * 2);
    const size_t hstep = (size_t)HALF * K * 2;
    const size_t tstep = 2 * hstep;
    const unsigned ldsw = (unsigned)wid * 1024u;
    const int aoff = lds_byte(wr * 64 + fr, fq * 8), boff = lds_byte(wc * 32 + fr, fq * 8);
#define PG8_SA(b, h) (((b) * 2 + (h)) * HTB)
#define PG8_SB(b, h) ((4 + (b) * 2 + (h)) * HTB)
#define PG8_STAGE(bufoff, gbase, voff) do { _Pragma("unroll") for (int _i = 0; _i < 2; ++_i) \
        __builtin_amdgcn_global_load_lds((const unsigned*)((const char*)(gbase) + (voff)[_i]), (PG8_LAS unsigned*)(lds + (bufoff) + ldsw + _i * 8192), 16, 0, 0); } while (0)
#define PG8_LDA(dst, b, h) do { _Pragma("unroll") for (int m = 0; m < 4; ++m) _Pragma("unroll") for (int k = 0; k < 2; ++k) dst[m][k] = *(const PG8_LAS bf16x8*)(lds + PG8_SA(b, h) + aoff + m * 2048 + k * 1024); } while (0)
#define PG8_LDB(dst, b, h) do { _Pragma("unroll") for (int n = 0; n < 2; ++n) _Pragma("unroll") for (int k = 0; k < 2; ++k) dst[n][k] = *(const PG8_LAS bf16x8*)(lds + PG8_SB(b, h) + boff + n * 2048 + k * 1024); } while (0)
#define PG8_MMA(ai, bj, At, Bt) do { __builtin_amdgcn_s_setprio(1); _Pragma("unroll") for (int m = 0; m < 4; ++m) _Pragma("unroll") for (int n = 0; n < 2; ++n) _Pragma("unroll") for (int k = 0; k < 2; ++k) \
        acc[ai][bj][m][n] = __builtin_amdgcn_mfma_f32_16x16x32_bf16(Bt[n][k], At[m][k], acc[ai][bj][m][n], 0, 0, 0); __builtin_amdgcn_s_setprio(0); } while (0)
#define PG8_WAIT_V(n) asm volatile("s_waitcnt vmcnt(" #n ")" ::: "memory")
#define PG8_WAIT_L(n) asm volatile("s_waitcnt lgkmcnt(" #n ")" ::: "memory")
#define PG8_BAR __builtin_amdgcn_s_barrier()
#define PG8_SCHED __builtin_amdgcn_sched_barrier(0)
    Unit cur, nxt; int ui = 0;
    if (!S.next(0, cur)) return;
    f32x4 acc[2][2][4][2];
#pragma unroll
    for (int a = 0; a < 2; ++a)
#pragma unroll
        for (int b = 0; b < 2; ++b)
#pragma unroll
            for (int m = 0; m < 4; ++m)
#pragma unroll
                for (int n = 0; n < 2; ++n) acc[a][b][m][n] = (f32x4){0.f, 0.f, 0.f, 0.f};
    bf16x8 At[4][2], B0[2][2], B1[2][2];
    const char* cA = (const char*)g.A + (size_t)cur.pm * tstep; const char* cB = (const char*)g.Bt + (size_t)cur.pn * tstep;
    S.a_ready(cur);
    if constexpr (SP2) {
        PG8_STAGE(PG8_SB(0, 0), cB, voffB); PG8_STAGE(PG8_SB(0, 1), cB + hstep, voffB); PG8_STAGE(PG8_SA(0, 0), cA, voffA); PG8_STAGE(PG8_SA(0, 1), cA + hstep, voffA);
        if (wr == 1) PG8_BAR;
        PG8_WAIT_V(2); PG8_BAR;
        PG8_STAGE(PG8_SB(1, 0), cB + kstep, voffB); PG8_STAGE(PG8_SA(1, 0), cA + kstep, voffA); PG8_STAGE(PG8_SB(1, 1), cB + hstep + kstep, voffB);
        PG8_WAIT_V(6); PG8_BAR;
    } else {
        PG8_STAGE(PG8_SB(0, 0), cB, voffB); PG8_STAGE(PG8_SA(0, 0), cA, voffA); PG8_STAGE(PG8_SB(0, 1), cB + hstep, voffB); PG8_STAGE(PG8_SA(0, 1), cA + hstep, voffA);
        if (wr == 1) PG8_BAR;
        PG8_WAIT_V(4); PG8_BAR;
        PG8_STAGE(PG8_SB(1, 0), cB + kstep, voffB); PG8_STAGE(PG8_SA(1, 0), cA + kstep, voffA); PG8_STAGE(PG8_SB(1, 1), cB + hstep + kstep, voffB);
        PG8_WAIT_V(6); PG8_BAR;
    }
    for (;;) {
        const bool has_next = S.next(ui + 1, nxt);
        const char* nA = has_next ? (const char*)g.A + (size_t)nxt.pm * tstep : cA; const char* nB = has_next ? (const char*)g.Bt + (size_t)nxt.pn * tstep : cB;
        for (int t = 0; t < nt; t += 2) {
            const bool last = (t == nt - 2);
            const char* a1 = cA + (size_t)(t + 1) * kstep;
            const char* a2 = last ? nA : cA + (size_t)(t + 2) * kstep; const char* b2 = last ? nB : cB + (size_t)(t + 2) * kstep;
            const char* a3 = a2 + kstep; const char* b3 = b2 + kstep;
            if (last && has_next) S.a_ready(nxt);
            if constexpr (SP2) {
            PG8_LDB(B0, 0, 0); PG8_LDB(B1, 0, 1); PG8_SCHED; PG8_LDA(At, 0, 0); PG8_STAGE(PG8_SA(1, 1), a1 + hstep, voffA);
            PG8_WAIT_V(8); PG8_WAIT_L(0); PG8_BAR; PG8_MMA(0, 0, At, B0); PG8_MMA(0, 1, At, B1); PG8_BAR; PG8_SCHED;
            PG8_LDA(At, 0, 1); PG8_STAGE(PG8_SB(0, 0), b2, voffB); PG8_STAGE(PG8_SB(0, 1), b2 + hstep, voffB); PG8_STAGE(PG8_SA(0, 0), a2, voffA);
            PG8_WAIT_V(8); PG8_WAIT_L(0); PG8_BAR; PG8_MMA(1, 0, At, B0); PG8_MMA(1, 1, At, B1); PG8_BAR; PG8_SCHED;
            PG8_LDB(B0, 1, 0); PG8_LDB(B1, 1, 1); PG8_SCHED; PG8_LDA(At, 1, 0); PG8_STAGE(PG8_SA(0, 1), a2 + hstep, voffA);
            PG8_WAIT_V(8); PG8_WAIT_L(0); PG8_BAR; PG8_MMA(0, 0, At, B0); PG8_MMA(0, 1, At, B1); PG8_BAR; PG8_SCHED;
            PG8_LDA(At, 1, 1); PG8_STAGE(PG8_SB(1, 0), b3, voffB); PG8_STAGE(PG8_SB(1, 1), b3 + hstep, voffB); PG8_STAGE(PG8_SA(1, 0), a3, voffA);
            PG8_WAIT_V(8); PG8_WAIT_L(0); PG8_BAR; PG8_MMA(1, 0, At, B0); PG8_MMA(1, 1, At, B1); PG8_BAR; PG8_SCHED;
            } else {
            PG8_LDB(B0, 0, 0); PG8_SCHED; PG8_LDA(At, 0, 0); PG8_STAGE(PG8_SA(1, 1), a1 + hstep, voffA);
            PG8_WAIT_L(8); PG8_BAR; PG8_WAIT_L(0); PG8_MMA(0, 0, At, B0); PG8_BAR; PG8_SCHED;
            PG8_LDB(B1, 0, 1); PG8_STAGE(PG8_SB(0, 0), b2, voffB);
            PG8_BAR; PG8_WAIT_L(0); PG8_MMA(0, 1, At, B1); PG8_BAR;
            PG8_LDA(At, 0, 1); PG8_STAGE(PG8_SA(0, 0), a2, voffA);
            PG8_BAR; PG8_WAIT_L(0); PG8_MMA(1, 0, At, B0); PG8_BAR; PG8_SCHED;
            PG8_STAGE(PG8_SB(0, 1), b2 + hstep, voffB);
            PG8_WAIT_V(6); PG8_BAR; PG8_MMA(1, 1, At, B1); PG8_BAR;
            PG8_LDB(B0, 1, 0); PG8_SCHED; PG8_LDA(At, 1, 0); PG8_STAGE(PG8_SA(0, 1), a2 + hstep, voffA);
            PG8_WAIT_L(8); PG8_BAR; PG8_WAIT_L(0); PG8_MMA(0, 0, At, B0); PG8_BAR; PG8_SCHED;
            PG8_LDB(B1, 1, 1); PG8_STAGE(PG8_SB(1, 0), b3, voffB);
            PG8_BAR; PG8_WAIT_L(0); PG8_MMA(0, 1, At, B1); PG8_BAR;
            PG8_LDA(At, 1, 1); PG8_STAGE(PG8_SA(1, 0), a3, voffA);
            PG8_BAR; PG8_WAIT_L(0); PG8_MMA(1, 0, At, B0); PG8_BAR; PG8_SCHED;
            PG8_STAGE(PG8_SB(1, 1), b3 + hstep, voffB);
            PG8_WAIT_V(6); PG8_BAR; PG8_MMA(1, 1, At, B1); PG8_BAR;
            }
        }
        if constexpr (ALIGN_EPI) { if (wr == 0) PG8_BAR; }
        if constexpr (!Epi::AFTER_DRAIN) { E(acc, cur, wr, wc, fr, fq); S.done(cur); }
        if (!has_next) break;
#pragma unroll
        for (int a = 0; a < 2; ++a)
#pragma unroll
            for (int b = 0; b < 2; ++b)
#pragma unroll
                for (int m = 0; m < 4; ++m)
#pragma unroll
                    for (int n = 0; n < 2; ++n) acc[a][b][m][n] = (f32x4){0.f, 0.f, 0.f, 0.f};
        cur = nxt; cA = nA; cB = nB; ++ui;
        if constexpr (ALIGN_EPI) { if (wr == 1) PG8_BAR; }
    }
    PG8_WAIT_V(0);
    if constexpr (!ALIGN_EPI) { if (wr == 0) PG8_BAR; }
    PG8_BAR;
    if constexpr (Epi::AFTER_DRAIN) { E.fused(acc, cur, wr, wc, fr, fq, lds, wid, lane); S.done(cur); }
#undef PG8_SA
#undef PG8_SB
#undef PG8_STAGE
#undef PG8_LDA
#undef PG8_LDB
#undef PG8_MMA
#undef PG8_WAIT_V
#undef PG8_WAIT_L
#undef PG8_BAR
#undef PG8_SCHED
}

template <int MODE>
DEV void gemm_run(const Params& p, const bf16_t* A, const bf16_t* Bt, int N, int K, char* smem) {
    Gemm g; g.A = A; g.Bt = Bt; g.M = MTOT; g.N = N; g.K = K;
    Order S; S.init(MTOT, N, gridDim.x, blockIdx.x);
    Epi<MODE> E; E.ob = MODE == 0 ? p.u : p.hid; E.hb = p.hb; E.zx = p.out; E.zm = p.zmeta;
    gemm_phase<Epi<MODE>, Order, true, true>((PG8_LAS unsigned char*)smem, g, S, E);
    __syncthreads();
}

DEV float softplus2(float z) {
    const float e = __builtin_amdgcn_exp2f(-fabsf(z));
    return fmaxf(z, 0.f) + __builtin_amdgcn_logf(1.0f + e);
}

constexpr int KS_STRIDE = 72;
constexpr int VT_STRIDE = 68;

DEV void attn_main_unit(const Params& p, int b, int h, int qb, char* smem) {
    bf16_t* Ks = (bf16_t*)smem;
    bf16_t* Vt = (bf16_t*)(smem + 64 * KS_STRIDE * 2);
    const int tid = tid_(), wid = tid >> 6, lane = tid & 63, ln = lane & 31, hh = lane >> 5;
    const int p0 = qb * 256 + wid * 32;
    bf16x8 qf[4];
    {
        const bf16_t* qrow = p.u + (size_t)(b * SEQ + p0 + ln) * DIN + h * 64 + 8 * hh;
#pragma unroll
        for (int s = 0; s < 4; ++s) qf[s] = *(const bf16x8*)(qrow + 16 * s);
    }
    f32x16 o0 = {}, o1 = {};
    float c = 0.f;
    const int ktmax = qb * 4 + 3;
    uint4 kreg; uint2 vreg0, vreg1;
    const int skey = tid >> 3, sdch = tid & 7, skp = tid & 31, sdc = tid >> 5;
    auto load_tile = [&](int kt) {
        int rk, rv0, rv1;
        if (kt >= 0) { rk = b * SEQ + kt * 64 + skey; rv0 = b * SEQ + kt * 64 + 2 * skp; rv1 = rv0 + 1; }
        else { rk = skey < NMETA ? MX + b * NMETA + skey : -1; rv0 = 2 * skp < NMETA ? MX + b * NMETA + 2 * skp : -1; rv1 = rv0 < 0 ? -1 : rv0 + 1; }
        kreg = rk >= 0 ? *(const uint4*)(p.u + (size_t)rk * DIN + 512 + h * 64 + sdch * 8) : make_uint4(0, 0, 0, 0);
        vreg0 = rv0 >= 0 ? *(const uint2*)(p.u + (size_t)rv0 * DIN + 1024 + h * 64 + sdc * 4) : make_uint2(0, 0);
        vreg1 = rv1 >= 0 ? *(const uint2*)(p.u + (size_t)rv1 * DIN + 1024 + h * 64 + sdc * 4) : make_uint2(0, 0);
    };
    load_tile(ktmax);
    for (int kt = ktmax; kt >= -1; --kt) {
        __syncthreads();
        *(uint4*)(Ks + skey * KS_STRIDE + sdch * 8) = kreg;
        {
            unsigned* vt = (unsigned*)(Vt + (sdc * 4) * VT_STRIDE + 2 * skp);
            vt[0] = (vreg0.x & 0xffffu) | (vreg1.x << 16);
            vt[VT_STRIDE / 2] = (vreg0.x >> 16) | (vreg1.x & 0xffff0000u);
            vt[VT_STRIDE] = (vreg0.y & 0xffffu) | (vreg1.y << 16);
            vt[VT_STRIDE / 2 * 3] = (vreg0.y >> 16) | (vreg1.y & 0xffff0000u);
        }
        __syncthreads();
        if (kt > -1) load_tile(kt - 1);
#pragma unroll
        for (int sub = 1; sub >= 0; --sub) {
            const int s0 = kt * 64 + sub * 32;
            if (kt < 0 ? (sub == 1) : (s0 > p0)) continue;
            const int lim = kt < 0 ? NMETA : (s0 == p0 ? ln : 32);
            f32x16 z = {};
#pragma unroll
            for (int s = 0; s < 4; ++s) {
                const bf16x8 kf = *(const bf16x8*)(Ks + (sub * 32 + ln) * KS_STRIDE + 16 * s + 8 * hh);
                z = __builtin_amdgcn_mfma_f32_32x32x16_bf16(kf, qf[s], z, 0, 0, 0);
            }
            float sp[16];
#pragma unroll
            for (int r = 0; r < 16; ++r) { const int kk = 8 * (r >> 2) + 4 * hh + (r & 3); sp[r] = kk < lim ? softplus2(z[r]) : 0.f; }
            float G[4], PG[4];
#pragma unroll
            for (int j = 0; j < 4; ++j) { G[j] = (sp[4 * j] + sp[4 * j + 1]) + (sp[4 * j + 2] + sp[4 * j + 3]); PG[j] = __shfl_xor(G[j], 32); }
            float st = 0.f, a[16];
#pragma unroll
            for (int j = 3; j >= 0; --j) {
                float run = st + (hh == 0 ? PG[j] : 0.f);
#pragma unroll
                for (int i = 3; i >= 0; --i) {
                    const int r = 4 * j + i, kk = 8 * j + 4 * hh + i;
                    run += sp[r];
                    a[r] = kk < lim ? __builtin_amdgcn_exp2f(z[r] - run - c) : 0.f;
                }
                st += G[j] + PG[j];
            }
            c += st;
#pragma unroll
            for (int m = 0; m < 2; ++m) {
                union { bf16x8 v; unsigned w[4]; } af;
                af.w[0] = pk_bf16(a[8 * m + 0], a[8 * m + 1]); af.w[1] = pk_bf16(a[8 * m + 2], a[8 * m + 3]);
                af.w[2] = pk_bf16(a[8 * m + 4], a[8 * m + 5]); af.w[3] = pk_bf16(a[8 * m + 6], a[8 * m + 7]);
                union { bf16x8 v; uint2 d[2]; } v0, v1;
                const bf16_t* vb = Vt + ln * VT_STRIDE + sub * 32 + 16 * m + 4 * hh;
                v0.d[0] = *(const uint2*)vb; v0.d[1] = *(const uint2*)(vb + 8);
                v1.d[0] = *(const uint2*)(vb + 32 * VT_STRIDE); v1.d[1] = *(const uint2*)(vb + 32 * VT_STRIDE + 8);
                o0 = __builtin_amdgcn_mfma_f32_32x32x16_bf16(v0.v, af.v, o0, 0, 0, 0);
                o1 = __builtin_amdgcn_mfma_f32_32x32x16_bf16(v1.v, af.v, o1, 0, 0, 0);
            }
        }
    }
    {
        bf16_t* orow = p.y + (size_t)(b * SEQ + p0 + ln) * D + h * 64 + 4 * hh;
#pragma unroll
        for (int j = 0; j < 4; ++j) {
            uint2 w; w.x = pk_bf16(o0[4 * j], o0[4 * j + 1]); w.y = pk_bf16(o0[4 * j + 2], o0[4 * j + 3]);
            *(uint2*)(orow + 8 * j) = w;
            w.x = pk_bf16(o1[4 * j], o1[4 * j + 1]); w.y = pk_bf16(o1[4 * j + 2], o1[4 * j + 3]);
            *(uint2*)(orow + 32 + 8 * j) = w;
        }
    }
    __syncthreads();
}

DEV void attn_meta_unit(const Params& p, int b, int h, char* smem) {
    float* qs = (float*)smem;
    float* ks = qs + 1024;
    float* vs = ks + 16 * 65;
    float* zs = vs + 1024;
    const int tid = tid_();
    for (int i = tid; i < 16 * 64; i += NTHREADS) {
        const int t = i >> 6, d = i & 63;
        const bf16_t* r = p.u + (size_t)(MX + b * NMETA + t) * DIN + h * 64 + d;
        qs[t * 64 + d] = __uint_as_float((unsigned)r[0] << 16);
        ks[t * 65 + d] = __uint_as_float((unsigned)r[512] << 16);
        vs[t * 64 + d] = __uint_as_float((unsigned)r[1024] << 16);
    }
    __syncthreads();
    if (tid < 256) {
        const int t = tid >> 4, s = tid & 15;
        float acc = 0.f;
        for (int d = 0; d < 64; ++d) acc += qs[t * 64 + d] * ks[s * 65 + d];
        zs[tid] = acc;
    }
    __syncthreads();
    {
        const int t = tid >> 5, d0 = (tid & 31) * 2;
        float c = 0.f, oa = 0.f, ob = 0.f;
        for (int s = t - 1; s >= 0; --s) {
            const float z = zs[t * 16 + s];
            c += softplus2(z);
            const float a = __builtin_amdgcn_exp2f(z - c);
            oa += a * vs[s * 64 + d0]; ob += a * vs[s * 64 + d0 + 1];
        }
        *(unsigned*)(p.y + (size_t)(MX + b * NMETA + t) * D + h * 64 + d0) = pk_bf16(oa, ob);
    }
    __syncthreads();
}

DEV void attn_phase(const Params& p, char* smem) {
    const int nmain = NB * 8 * 8, ntot = nmain + NB * 8;
    for (int u = blockIdx.x; u < ntot; u += gridDim.x) {
        if (u < nmain) {
            const int qb = 7 - u / (NB * 8), r = u % (NB * 8);
            attn_main_unit(p, r >> 3, r & 7, qb, smem);
        } else {
            const int r = u - nmain;
            attn_meta_unit(p, r >> 3, r & 7, smem);
        }
    }
}

DEV float sigmoidf_(float v) { return 1.0f / (1.0f + __expf(-v)); }

DEV void post_unit(const Params& p, int layer, int b, int q0, int T, char* smem) {
    float* hc = (float*)smem;
    float* cv = hc + 62 * 256;
    const int tid = tid_(), wid = tid >> 6, lane = tid & 63;
    for (int i = tid; i < 62 * 32; i += NTHREADS) {
        const int r = i >> 5, c8 = (i & 31) * 8;
        const int q = q0 - 30 + r;
        float o[8];
        if (q >= 0 && r < T + 30) {
            const bf16_t* src = p.u + (size_t)row_of(b, q) * DIN + 1536 + c8;
            const uint4 a = *(const uint4*)src, g = *(const uint4*)(src + 256);
            o[0] = bflo(a.x) * sigmoidf_(bflo(g.x)); o[1] = bfhi(a.x) * sigmoidf_(bfhi(g.x));
            o[2] = bflo(a.y) * sigmoidf_(bflo(g.y)); o[3] = bfhi(a.y) * sigmoidf_(bfhi(g.y));
            o[4] = bflo(a.z) * sigmoidf_(bflo(g.z)); o[5] = bfhi(a.z) * sigmoidf_(bfhi(g.z));
            o[6] = bflo(a.w) * sigmoidf_(bflo(g.w)); o[7] = bfhi(a.w) * sigmoidf_(bfhi(g.w));
        } else {
#pragma unroll
            for (int k = 0; k < 8; ++k) o[k] = 0.f;
        }
        *(float4*)(hc + r * 256 + c8) = make_float4(o[0], o[1], o[2], o[3]);
        *(float4*)(hc + r * 256 + c8 + 4) = make_float4(o[4], o[5], o[6], o[7]);
    }
    __syncthreads();
    {
        const int ch = tid & 255, half = tid >> 8;
        const float* wdw = p.w_conf_dw + (size_t)layer * 31 * 256 + ch;
        float w[31];
#pragma unroll
        for (int k = 0; k < 31; ++k) w[k] = wdw[k * 256];
        const float bias = p.b_conf_dw[layer * 256 + ch];
        float acc[16];
#pragma unroll
        for (int i = 0; i < 16; ++i) acc[i] = bias;
        const float* src = hc + (half * 16) * 256 + ch;
#pragma unroll
        for (int j = 0; j < 46; ++j) {
            const float v = src[j * 256];
#pragma unroll
            for (int i = 0; i < 16; ++i) if (j - i >= 0 && j - i <= 30) acc[i] += w[j - i] * v;
        }
#pragma unroll
        for (int i = 0; i < 16; ++i) cv[(half * 16 + i) * 256 + ch] = acc[i];
    }
    __syncthreads();
    const float* gmix = p.g_mix + (size_t)layer * D;
    for (int i = wid; i < T; i += 8) {
        const int q = q0 + i, row = row_of(b, q);
        bf16_t* yrow = p.y + (size_t)row * D;
        {
            const int c0 = lane * 4;
            const float4 v = *(const float4*)(cv + i * 256 + c0);
            const float mu = wave_sum((v.x + v.y) + (v.z + v.w)) * (1.0f / 256.0f);
            const float dx = v.x - mu, dy = v.y - mu, dz = v.z - mu, dw = v.w - mu;
            const float rstd = rsqrtf(wave_sum((dx * dx + dy * dy) + (dz * dz + dw * dw)) * (1.0f / 256.0f) + 1e-5f);
            const float4 g = *(const float4*)(p.ln_conf_g + layer * 256 + c0), bb = *(const float4*)(p.ln_conf_b + layer * 256 + c0);
            float t0 = dx * rstd * g.x + bb.x, t1 = dy * rstd * g.y + bb.y, t2 = dz * rstd * g.z + bb.z, t3 = dw * rstd * g.w + bb.w;
            t0 *= sigmoidf_(t0); t1 *= sigmoidf_(t1); t2 *= sigmoidf_(t2); t3 *= sigmoidf_(t3);
            const float r = rsqrtf(wave_sum((t0 * t0 + t1 * t1) + (t2 * t2 + t3 * t3)) * (1.0f / 256.0f) + 1e-6f);
            const float4 gm = *(const float4*)(gmix + 512 + c0);
            uint2 w; w.x = pk_bf16(t0 * r * gm.x, t1 * r * gm.y); w.y = pk_bf16(t2 * r * gm.z, t3 * r * gm.w);
            *(uint2*)(yrow + 512 + c0) = w;
        }
        {
            const int c0 = lane * 4;
            float s0 = 0.f, s1 = 0.f, s2 = 0.f, s3 = 0.f;
#pragma unroll
            for (int k = 0; k < 3; ++k) {
                const int qq = q - 2 + k;
                if (qq >= 0) {
                    const bf16_t* src = p.u + (size_t)row_of(b, qq) * DIN + 2304 + c0;
                    const uint2 cg_ = *(const uint2*)src, hv = *(const uint2*)(src + 256);
                    const float4 wk = *(const float4*)(p.w_short_dw + (size_t)layer * 3 * 256 + k * 256 + c0);
                    s0 += wk.x * bflo(cg_.x) * bflo(hv.x); s1 += wk.y * bfhi(cg_.x) * bfhi(hv.x);
                    s2 += wk.z * bflo(cg_.y) * bflo(hv.y); s3 += wk.w * bfhi(cg_.y) * bfhi(hv.y);
                }
            }
            const uint2 bg = *(const uint2*)(p.u + (size_t)row * DIN + 2048 + c0);
            s0 *= bflo(bg.x); s1 *= bfhi(bg.x); s2 *= bflo(bg.y); s3 *= bfhi(bg.y);
            const float r = rsqrtf(wave_sum((s0 * s0 + s1 * s1) + (s2 * s2 + s3 * s3)) * (1.0f / 256.0f) + 1e-6f);
            const float4 gm = *(const float4*)(gmix + 768 + c0);
            uint2 w; w.x = pk_bf16(s0 * r * gm.x, s1 * r * gm.y); w.y = pk_bf16(s2 * r * gm.z, s3 * r * gm.w);
            *(uint2*)(yrow + 768 + c0) = w;
        }
        {
            const int c0 = lane * 8;
            const uint4 ov = *(const uint4*)(yrow + c0);
            float f[8] = {bflo(ov.x), bfhi(ov.x), bflo(ov.y), bfhi(ov.y), bflo(ov.z), bfhi(ov.z), bflo(ov.w), bfhi(ov.w)};
            float ss = 0.f;
#pragma unroll
            for (int k = 0; k < 8; ++k) ss += f[k] * f[k];
            const float r = rsqrtf(wave_sum(ss) * (1.0f / 512.0f) + 1e-6f);
            const float4 g0 = *(const float4*)(gmix + c0), g1 = *(const float4*)(gmix + c0 + 4);
            uint4 w;
            w.x = pk_bf16(f[0] * r * g0.x, f[1] * r * g0.y); w.y = pk_bf16(f[2] * r * g0.z, f[3] * r * g0.w);
            w.z = pk_bf16(f[4] * r * g1.x, f[5] * r * g1.y); w.w = pk_bf16(f[6] * r * g1.z, f[7] * r * g1.w);
            *(uint4*)(yrow + c0) = w;
        }
    }
    __syncthreads();
}

DEV void post_phase(const Params& p, int layer, char* smem) {
    const int nx = NB * (SEQ / 32), ntot = nx + NB;
    for (int u = blockIdx.x; u < ntot; u += gridDim.x) {
        if (u < nx) post_unit(p, layer, u / (SEQ / 32), NMETA + (u % (SEQ / 32)) * 32, 32, smem);
        else post_unit(p, layer, u - nx, 0, NMETA, smem);
    }
}

constexpr int NPHASE = 1 + DEPTH * 8;

DEV void run_phase(const Params& p, int ph, char* smem) {
#ifdef TESTP
    const int l = (ph - 1) >> 3, s = TESTP;
    if (TESTP == 8) { prologue_phase(p, smem); return; }
#else
    if (ph == 0) { prologue_phase(p, smem); return; }
    const int l = (ph - 1) >> 3, s = (ph - 1) & 7;
#endif
    switch (s) {
        case 0: gemm_run<0>(p, p.hb, p.wt_in + (size_t)l * D * DIN, DIN, D, smem); break;
        case 1: attn_phase(p, smem); break;
        case 2: post_phase(p, l, smem); break;
        case 3: gemm_run<2>(p, p.y, p.wt_out + (size_t)l * D * D, D, D, smem); break;
        case 4: ln_phase(p, p.ln_mix_g + l * D, p.ln_mix_b + l * D, false); break;
        case 5: gemm_run<1>(p, p.hb, p.wt_ff1 + (size_t)l * D * DFF, DFF, D, smem); break;
        case 6: gemm_run<2>(p, p.hid, p.wt_ff2 + (size_t)l * D * DFF, D, DFF, smem); break;
        default: ln_phase(p, p.ln_ff_g + l * D, p.ln_ff_b + l * D, l == DEPTH - 1); break;
    }
}

__global__ void __launch_bounds__(NTHREADS, 2) mega(Params p, int ph_begin, int ph_end) {
    extern __shared__ __attribute__((aligned(16))) char smem[];
    cg::grid_group grid = cg::this_grid();
    for (int ph = ph_begin; ph < ph_end; ++ph) {
        run_phase(p, ph, smem);
        if (ph + 1 < ph_end) grid.sync();
    }
}

extern "C" void kernel_launch(void* const* d_in, const int* in_sizes, int n_in, void* d_out, int out_size, void* d_ws, size_t ws_size,
                              hipStream_t stream) {
    static int grid_blocks = 0;
    if (!grid_blocks) {
        int dev = 0, cus = 0, per_cu = 0;
        hipGetDevice(&dev);
        hipDeviceGetAttribute(&cus, hipDeviceAttributeMultiprocessorCount, dev);
        hipFuncSetAttribute((const void*)mega, hipFuncAttributeMaxDynamicSharedMemorySize, LDS_BYTES);
        hipOccupancyMaxActiveBlocksPerMultiprocessor(&per_cu, mega, NTHREADS, LDS_BYTES);
        if (per_cu < 1) per_cu = 1;
        grid_blocks = cus * (per_cu > 1 ? 1 : per_cu);
    }
    Params p{};
    const float* const* in = (const float* const*)d_in;
    p.x = in[0]; p.meta = in[1]; p.ln_in_g = in[2]; p.ln_in_b = in[3]; p.w_in = in[4]; p.w_conf_dw = in[5]; p.b_conf_dw = in[6];
    p.ln_conf_g = in[7]; p.ln_conf_b = in[8]; p.w_short_dw = in[9]; p.g_mix = in[10]; p.w_out = in[11]; p.ln_mix_g = in[12];
    p.ln_mix_b = in[13]; p.w_ff1 = in[14]; p.w_ff2 = in[15]; p.ln_ff_g = in[16]; p.ln_ff_b = in[17];
    p.out = (float*)d_out;
    char* ws = (char*)d_ws;
    size_t off = 0;
    auto take = [&](size_t bytes) { char* r = ws + off; off += (bytes + 255) & ~(size_t)255; return r; };
    p.wt_in = (bf16_t*)take((size_t)DEPTH * D * DIN * 2);
    p.wt_out = (bf16_t*)take((size_t)DEPTH * D * D * 2);
    p.wt_ff1 = (bf16_t*)take((size_t)DEPTH * D * DFF * 2);
    p.wt_ff2 = (bf16_t*)take((size_t)DEPTH * D * DFF * 2);
    p.hb = (bf16_t*)take((size_t)MTOT * D * 2);
    p.zmeta = (float*)take((size_t)NB * NMETA * D * 4);
    p.hid = (bf16_t*)take((size_t)MTOT * DFF * 2);
    p.u = p.hid;
    p.y = p.hid + (size_t)MTOT * DIN;
    if (off > ws_size) { fprintf(stderr, "workspace too small: need %zu have %zu\n", off, ws_size); return; }
#if ONE_LAUNCH
    int b = 0, e = NPHASE;
    void* args[] = {&p, &b, &e};
    hipError_t err = hipLaunchCooperativeKernel((const void*)mega, dim3(grid_blocks), dim3(NTHREADS), args, LDS_BYTES, stream);
    if (err != hipSuccess) fprintf(stderr, "cooperative launch failed: %s (grid %d)\n", hipGetErrorString(err), grid_blocks);
#else
    for (int ph = 0; ph < NPHASE; ++ph) {
        int b = ph, e = ph + 1;
        void* args[] = {&p, &b, &e};
        hipError_t err = hipLaunchCooperativeKernel((const void*)mega, dim3(grid_blocks), dim3(NTHREADS), args, LDS_BYTES, stream);
        if (err != hipSuccess) fprintf(stderr, "launch failed: %s\n", hipGetErrorString(err));
    }
#endif
}
```

```cpp
#include <hip/hip_runtime.h>
#include <hip/hip_cooperative_groups.h>
#include <cstdint>
#include <cstdio>
namespace cg = cooperative_groups;

#ifndef ONE_LAUNCH
#define ONE_LAUNCH 1
#endif

#define DEV __device__ __forceinline__
__device__ __forceinline__ int tid_() { int t = threadIdx.x; asm volatile("" : "+v"(t)); return t; }
typedef unsigned short bf16_t;
typedef short bf16x8 __attribute__((ext_vector_type(8)));
typedef float f32x4 __attribute__((ext_vector_type(4)));
typedef float f32x16 __attribute__((ext_vector_type(16)));

constexpr int D = 1024, NB = 16, SEQ = 2048, NMETA = 16;
constexpr int MX = NB * SEQ;
constexpr int MTOT = MX + NB * NMETA;
constexpr int DIN = 2816, DFF = 4096, DEPTH = 4;
constexpr float ALPHA = 1.681792830507429f;
constexpr float QSCALE = 0.125f * 1.4426950408889634f;
constexpr int NTHREADS = 512;
constexpr int LDS_BYTES = 131072;

struct Params {
    const float *x, *meta, *ln_in_g, *ln_in_b, *w_in, *w_conf_dw, *b_conf_dw, *ln_conf_g, *ln_conf_b, *w_short_dw, *g_mix,
        *w_out, *ln_mix_g, *ln_mix_b, *w_ff1, *w_ff2, *ln_ff_g, *ln_ff_b;
    float* out;
    bf16_t *wt_in, *wt_out, *wt_ff1, *wt_ff2, *hb, *u, *y, *hid;
    float* zmeta;
};

DEV unsigned pk_bf16(float lo, float hi) { unsigned r; asm("v_cvt_pk_bf16_f32 %0, %1, %2" : "=v"(r) : "v"(lo), "v"(hi)); return r; }
DEV float bflo(unsigned w) { return __uint_as_float(w << 16); }
DEV float bfhi(unsigned w) { return __uint_as_float(w & 0xffff0000u); }
DEV float wave_sum(float v) {
#pragma unroll
    for (int o = 32; o >= 1; o >>= 1) v += __shfl_xor(v, o);
    return v;
}
DEV float* zrow(const Params& p, int row) { return row < MX ? p.out + (size_t)row * D : p.zmeta + (size_t)(row - MX) * D; }
DEV int row_of(int b, int q) { return q < NMETA ? MX + b * NMETA + q : b * SEQ + (q - NMETA); }

DEV void transpose_unit(const float* __restrict__ W, bf16_t* __restrict__ Wt, int K, int N, int kt, int nt, float* tile) {
    const int tid = tid_();
    {
        const int kr = tid >> 3, nc = (tid & 7) * 8;
        const float* src = W + (size_t)(kt * 64 + kr) * N + nt * 64 + nc;
        const float4 a = *(const float4*)src, b = *(const float4*)(src + 4);
        float* t = tile + kr * 65 + nc;
        t[0] = a.x; t[1] = a.y; t[2] = a.z; t[3] = a.w; t[4] = b.x; t[5] = b.y; t[6] = b.z; t[7] = b.w;
    }
    __syncthreads();
    {
        const int n = tid >> 3, kc = (tid & 7) * 8;
        const float* t = tile + kc * 65 + n;
        uint4 w;
        w.x = pk_bf16(t[0], t[65]); w.y = pk_bf16(t[130], t[195]); w.z = pk_bf16(t[260], t[325]); w.w = pk_bf16(t[390], t[455]);
        *(uint4*)(Wt + (size_t)(nt * 64 + n) * K + kt * 64 + kc) = w;
    }
    __syncthreads();
}

DEV void ln_row_store(const float4 (&v)[4], const float* __restrict__ g, const float* __restrict__ b, bf16_t* dst, float* dstf, int lane) {
    float s = 0.f;
#pragma unroll
    for (int i = 0; i < 4; ++i) s += (v[i].x + v[i].y) + (v[i].z + v[i].w);
    const float mu = wave_sum(s) * (1.0f / D);
    float q = 0.f;
#pragma unroll
    for (int i = 0; i < 4; ++i) { const float a = v[i].x - mu, bb = v[i].y - mu, c = v[i].z - mu, d = v[i].w - mu; q += (a * a + bb * bb) + (c * c + d * d); }
    const float rstd = rsqrtf(wave_sum(q) * (1.0f / D) + 1e-5f);
#pragma unroll
    for (int i = 0; i < 4; ++i) {
        const int col = lane * 4 + 256 * i;
        const float4 gg = *(const float4*)(g + col), bb = *(const float4*)(b + col);
        float4 o;
        o.x = (v[i].x - mu) * rstd * gg.x + bb.x; o.y = (v[i].y - mu) * rstd * gg.y + bb.y;
        o.z = (v[i].z - mu) * rstd * gg.z + bb.z; o.w = (v[i].w - mu) * rstd * gg.w + bb.w;
        if (dst) { uint2 w; w.x = pk_bf16(o.x, o.y); w.y = pk_bf16(o.z, o.w); *(uint2*)(dst + col) = w; }
        if (dstf) *(float4*)(dstf + col) = o;
    }
}

DEV void prologue_phase(const Params& p, char* smem) {
    float* tile = (float*)smem;
    const int n_in = 16 * 44, n_out = 16 * 16, n_f1 = 16 * 64, n_f2 = 64 * 16;
    const int per_layer = n_in + n_out + n_f1 + n_f2;
    for (int u = blockIdx.x; u < per_layer * DEPTH; u += gridDim.x) {
        const int l = u / per_layer; int r = u % per_layer;
        if (r < n_in) { transpose_unit(p.w_in + (size_t)l * D * DIN, p.wt_in + (size_t)l * D * DIN, D, DIN, r / 44, r % 44, tile); continue; }
        r -= n_in;
        if (r < n_out) { transpose_unit(p.w_out + (size_t)l * D * D, p.wt_out + (size_t)l * D * D, D, D, r / 16, r % 16, tile); continue; }
        r -= n_out;
        if (r < n_f1) { transpose_unit(p.w_ff1 + (size_t)l * D * DFF, p.wt_ff1 + (size_t)l * D * DFF, D, DFF, r / 64, r % 64, tile); continue; }
        r -= n_f1;
        transpose_unit(p.w_ff2 + (size_t)l * D * DFF, p.wt_ff2 + (size_t)l * D * DFF, DFF, D, r / 16, r % 16, tile);
    }
    const int tid = tid_(), wid = tid >> 6, lane = tid & 63;
    for (int row = blockIdx.x * 8 + wid; row < MTOT; row += gridDim.x * 8) {
        const float* src = row < MX ? p.x + (size_t)row * D : p.meta + (size_t)((row - MX) & 15) * D;
        float4 v[4];
#pragma unroll
        for (int i = 0; i < 4; ++i) v[i] = *(const float4*)(src + lane * 4 + 256 * i);
        ln_row_store(v, p.ln_in_g, p.ln_in_b, p.hb + (size_t)row * D, nullptr, lane);
    }
}

DEV void ln_phase(const Params& p, const float* g, const float* b, bool final) {
    const int tid = tid_(), wid = tid >> 6, lane = tid & 63;
    for (int row = blockIdx.x * 8 + wid; row < MTOT; row += gridDim.x * 8) {
        float* src = zrow(p, row);
        float4 v[4];
#pragma unroll
        for (int i = 0; i < 4; ++i) v[i] = *(const float4*)(src + lane * 4 + 256 * i);
        if (final) { if (row < MX) ln_row_store(v, g, b, nullptr, src, lane); }
        else ln_row_store(v, g, b, p.hb + (size_t)row * D, nullptr, lane);
    }
}

#define PG8_LAS __attribute__((address_space(3)))
constexpr int BM = 256, BK = 64, HALF = 128, HTB = HALF * BK * 2, STAGE_BYTES = 8 * HTB;
DEV int lds_byte(int r, int c) { const int st = (r >> 4) * 2 + (c >> 5), rr = r & 15, cc = c & 31, ob = rr * 64 + cc * 2; return st * 1024 + (ob ^ (((ob >> 9) & 1) << 5)); }
DEV void stage_rc(int b, int& R, int& C) { const int st = b / 1024, sb = b % 1024, swz = sb ^ (((sb >> 9) & 1) << 5); R = (st >> 1) * 16 + swz / 64; C = (st & 1) * 32 + (swz % 64) / 2; }
DEV int perm32(int rho) { const int n = rho >> 4, i = rho & 15; return 8 * (i >> 2) + 4 * n + (i & 3); }
struct Unit { int pm, pn; };
struct Gemm { const bf16_t* A; const bf16_t* Bt; int M, N, K; };

struct Order {
    int nM, nN, nwg, G, c;
    DEV void init(int M, int N, int G_, int c_) { nM = M / BM; nN = N / BM; nwg = nM * nN; G = G_; c = c_; }
    DEV bool next(int i, Unit& u) const {
        const int L = i * G + c; if (L >= nwg) return false;
        const int nig = 8 * nN, gid = L / nig, fm = gid * 8, gsz = (nM - fm) < 8 ? (nM - fm) : 8;
        u.pm = fm + ((L % nig) % gsz); u.pn = (L % nig) / gsz; return true;
    }
    DEV void a_ready(const Unit&) const {}
    DEV void done(const Unit&) const {}
};

template <int MODE> struct Epi {
    static constexpr bool PERM = true, AFTER_DRAIN = false;
    bf16_t* ob;
    const bf16_t* hb;
    float* zx; float* zm;
    DEV void operator()(const f32x4 (&acc)[2][2][4][2], const Unit& u, int wr, int wc, int fr, int fq) const {
        const int row0 = u.pm * BM + wr * 64 + fr, col0 = u.pn * BM + wc * 32 + 8 * fq;
#pragma unroll
        for (int ai = 0; ai < 2; ++ai)
#pragma unroll
            for (int m = 0; m < 4; ++m) {
                const int row = row0 + ai * HALF + m * 16;
#pragma unroll
                for (int bj = 0; bj < 2; ++bj) {
                    const int col = col0 + bj * HALF;
                    f32x4 v0 = acc[ai][bj][m][0], v1 = acc[ai][bj][m][1];
                    if (MODE == 0) {
                        if (col < 512) { v0 = v0 * QSCALE; v1 = v1 * QSCALE; }
                        uint4 w; w.x = pk_bf16(v0[0], v0[1]); w.y = pk_bf16(v0[2], v0[3]); w.z = pk_bf16(v1[0], v1[1]); w.w = pk_bf16(v1[2], v1[3]);
                        *(uint4*)(ob + (size_t)row * DIN + col) = w;
                    } else if (MODE == 1) {
#pragma unroll
                        for (int k = 0; k < 4; ++k) { v0[k] = fmaxf(v0[k], 0.f); v1[k] = fmaxf(v1[k], 0.f); }
                        v0 = v0 * v0; v1 = v1 * v1;
                        uint4 w; w.x = pk_bf16(v0[0], v0[1]); w.y = pk_bf16(v0[2], v0[3]); w.z = pk_bf16(v1[0], v1[1]); w.w = pk_bf16(v1[2], v1[3]);
                        *(uint4*)(ob + (size_t)row * DFF + col) = w;
                    } else {
                        const uint4 hw = *(const uint4*)(hb + (size_t)row * D + col);
                        f32x4 o0, o1;
                        o0[0] = ALPHA * bflo(hw.x) + v0[0]; o0[1] = ALPHA * bfhi(hw.x) + v0[1]; o0[2] = ALPHA * bflo(hw.y) + v0[2]; o0[3] = ALPHA * bfhi(hw.y) + v0[3];
                        o1[0] = ALPHA * bflo(hw.z) + v1[0]; o1[1] = ALPHA * bfhi(hw.z) + v1[1]; o1[2] = ALPHA * bflo(hw.w) + v1[2]; o1[3] = ALPHA * bfhi(hw.w) + v1[3];
                        float* zr = (row < MX ? zx + (size_t)row * D : zm + (size_t)(row - MX) * D) + col;
                        *(f32x4*)zr = o0; *(f32x4*)(zr + 4) = o1;
                    }
                }
            }
    }
};

template <class Epi, class Sched, bool ALIGN_EPI = false, bool SP2 = false>
__device__ __forceinline__ void gemm_phase(PG8_LAS unsigned char* lds, const Gemm g, const Sched& S, const Epi& E) {
    const int tid = tid_(), wid = __builtin_amdgcn_readfirstlane(tid >> 6), lane = tid & 63, wr = wid >> 2, wc = wid & 3, fr = lane & 15, fq = lane >> 4;
    const int K = g.K, nt = K / BK;
    unsigned voffA[2], voffB[2];
#pragma unroll
    for (int i = 0; i < 2; ++i) { int R, C; stage_rc(tid * 16 + i * 8192, R, C); const int Rb = Epi::PERM ? ((R & ~31) + perm32(R & 31)) : R;
        voffA[i] = (unsigned)(R * K + C) * 2u; voffB[i] = (unsigned)(Rb * K + C) * 2u; }
    const size_t kstep = (size_t)(BK * 2);
    const size_t hstep = (size_t)HALF * K * 2;
    const size_t tstep = 2 * hstep;
    const unsigned ldsw = (unsigned)wid * 1024u;
    const int aoff = lds_byte(wr * 64 + fr, fq * 8), boff = lds_byte(wc * 32 + fr, fq * 8);
#define PG8_SA(b, h) (((b) * 2 + (h)) * HTB)
#define PG8_SB(b, h) ((4 + (b) * 2 + (h)) * HTB)
#define PG8_STAGE(bufoff, gbase, voff) do { _Pragma("unroll") for (int _i = 0; _i < 2; ++_i) \
        __builtin_amdgcn_global_load_lds((const unsigned*)((const char*)(gbase) + (voff)[_i]), (PG8_LAS unsigned*)(lds + (bufoff) + ldsw + _i * 8192), 16, 0, 0); } while (0)
#define PG8_LDA(dst, b, h) do { _Pragma("unroll") for (int m = 0; m < 4; ++m) _Pragma("unroll") for (int k = 0; k < 2; ++k) dst[m][k] = *(const PG8_LAS bf16x8*)(lds + PG8_SA(b, h) + aoff + m * 2048 + k * 1024); } while (0)
#define PG8_LDB(dst, b, h) do { _Pragma("unroll") for (int n = 0; n < 2; ++n) _Pragma("unroll") for (int k = 0; k < 2; ++k) dst[n][k] = *(const PG8_LAS bf16x8*)(lds + PG8_SB(b, h) + boff + n * 2048 + k * 1024); } while (0)
#define PG8_MMA(ai, bj, At, Bt) do { __builtin_amdgcn_s_setprio(1); _Pragma("unroll") for (int m = 0; m < 4; ++m) _Pragma("unroll") for (int n = 0; n < 2; ++n) _Pragma("unroll") for (int k = 0; k < 2; ++k) \
        acc[ai][bj][m][n] = __builtin_amdgcn_mfma_f32_16x16x32_bf16(Bt[n][k], At[m][k], acc[ai][bj][m][n], 0, 0, 0); __builtin_amdgcn_s_setprio(0); } while (0)
#define PG8_WAIT_V(n) asm volatile("s_waitcnt vmcnt(" #n ")" ::: "memory")
#define PG8_WAIT_L(n) asm volatile("s_waitcnt lgkmcnt(" #n ")" ::: "memory")
#define PG8_BAR __builtin_amdgcn_s_barrier()
#define PG8_SCHED __builtin_amdgcn_sched_barrier(0)
    Unit cur, nxt; int ui = 0;
    if (!S.next(0, cur)) return;
    f32x4 acc[2][2][4][2];
#pragma unroll
    for (int a = 0; a < 2; ++a)
#pragma unroll
        for (int b = 0; b < 2; ++b)
#pragma unroll
            for (int m = 0; m < 4; ++m)
#pragma unroll
                for (int n = 0; n < 2; ++n) acc[a][b][m][n] = (f32x4){0.f, 0.f, 0.f, 0.f};
    bf16x8 At[4][2], B0[2][2], B1[2][2];
    const char* cA = (const char*)g.A + (size_t)cur.pm * tstep; const char* cB = (const char*)g.Bt + (size_t)cur.pn * tstep;
    S.a_ready(cur);
    if constexpr (SP2) {
        PG8_STAGE(PG8_SB(0, 0), cB, voffB); PG8_STAGE(PG8_SB(0, 1), cB + hstep, voffB); PG8_STAGE(PG8_SA(0, 0), cA, voffA); PG8_STAGE(PG8_SA(0, 1), cA + hstep, voffA);
        if (wr == 1) PG8_BAR;
        PG8_WAIT_V(2); PG8_BAR;
        PG8_STAGE(PG8_SB(1, 0), cB + kstep, voffB); PG8_STAGE(PG8_SA(1, 0), cA + kstep, voffA); PG8_STAGE(PG8_SB(1, 1), cB + hstep + kstep, voffB);
        PG8_WAIT_V(6); PG8_BAR;
    } else {
        PG8_STAGE(PG8_SB(0, 0), cB, voffB); PG8_STAGE(PG8_SA(0, 0), cA, voffA); PG8_STAGE(PG8_SB(0, 1), cB + hstep, voffB); PG8_STAGE(PG8_SA(0, 1), cA + hstep, voffA);
        if (wr == 1) PG8_BAR;
        PG8_WAIT_V(4); PG8_BAR;
        PG8_STAGE(PG8_SB(1, 0), cB + kstep, voffB); PG8_STAGE(PG8_SA(1, 0), cA + kstep, voffA); PG8_STAGE(PG8_SB(1, 1), cB + hstep + kstep, voffB);
        PG8_WAIT_V(6); PG8_BAR;
    }
    for (;;) {
        const bool has_next = S.next(ui + 1, nxt);
        const char* nA = has_next ? (const char*)g.A + (size_t)nxt.pm * tstep : cA; const char* nB = has_next ? (const char*)g.Bt + (size_t)nxt.pn * tstep : cB;
        for (int t = 0; t < nt; t += 2) {
            const bool last = (t == nt - 2);
            const char* a1 = cA + (size_t)(t + 1) * kstep;
            const char* a2 = last ? nA : cA + (size_t)(t + 2) * kstep; const char* b2 = last ? nB : cB + (size_t)(t + 2) * kstep;
            const char* a3 = a2 + kstep; const char* b3 = b2 + kstep;
            if (last && has_next) S.a_ready(nxt);
            if constexpr (SP2) {
            PG8_LDB(B0, 0, 0); PG8_LDB(B1, 0, 1); PG8_SCHED; PG8_LDA(At, 0, 0); PG8_STAGE(PG8_SA(1, 1), a1 + hstep, voffA);
            PG8_WAIT_V(8); PG8_WAIT_L(0); PG8_BAR; PG8_MMA(0, 0, At, B0); PG8_MMA(0, 1, At, B1); PG8_BAR; PG8_SCHED;
            PG8_LDA(At, 0, 1); PG8_STAGE(PG8_SB(0, 0), b2, voffB); PG8_STAGE(PG8_SB(0, 1), b2 + hstep, voffB); PG8_STAGE(PG8_SA(0, 0), a2, voffA);
            PG8_WAIT_V(8); PG8_WAIT_L(0); PG8_BAR; PG8_MMA(1, 0, At, B0); PG8_MMA(1, 1, At, B1); PG8_BAR; PG8_SCHED;
            PG8_LDB(B0, 1, 0); PG8_LDB(B1, 1, 1); PG8_SCHED; PG8_LDA(At, 1, 0); PG8_STAGE(PG8_SA(0, 1), a2 + hstep, voffA);
            PG8_WAIT_V(8); PG8_WAIT_L(0); PG8_BAR; PG8_MMA(0, 0, At, B0); PG8_MMA(0, 1, At, B1); PG8_BAR; PG8_SCHED;
            PG8_LDA(At, 1, 1); PG8_STAGE(PG8_SB(1, 0), b3, voffB); PG8_STAGE(PG8_SB(1, 1), b3 + hstep, voffB); PG8_STAGE(PG8_SA(1, 0), a3, voffA);
            PG8_WAIT_V(8); PG8_WAIT_L(0); PG8_BAR; PG8_MMA(1, 0, At, B0); PG8_MMA(1, 1, At, B1); PG8_BAR; PG8_SCHED;
            } else {
            PG8_LDB(B0, 0, 0); PG8_SCHED; PG8_LDA(At, 0, 0); PG8_STAGE(PG8_SA(1, 1), a1 + hstep, voffA);
            PG8_WAIT_L(8); PG8_BAR; PG8_WAIT_L(0); PG8_MMA(0, 0, At, B0); PG8_BAR; PG8_SCHED;
            PG8_LDB(B1, 0, 1); PG8_STAGE(PG8_SB(0, 0), b2, voffB);
            PG8_BAR; PG8_WAIT_L(0); PG8_MMA(0, 1, At, B1); PG8_BAR;
            PG8_LDA(At, 0, 1); PG8_STAGE(PG8_SA(0, 0), a2, voffA);
            PG8_BAR; PG8_WAIT_L(0); PG8_MMA(1, 0, At, B0); PG8_BAR; PG8_SCHED;
            PG8_STAGE(PG8_SB(0, 1), b2 + hstep, voffB);
            PG8_WAIT_V(6); PG8_BAR; PG8_MMA(1, 1, At, B1); PG8_BAR;
            PG8_LDB(B0, 1, 0); PG8_SCHED; PG8_LDA(At, 1, 0); PG8_STAGE(PG8_SA(0, 1), a2 + hstep, voffA);
            PG8_WAIT_L(8); PG8_BAR; PG8_WAIT_L(0); PG8_MMA(0, 0, At, B0); PG8_BAR; PG8_SCHED;
            PG8_LDB(B1, 1, 1); PG8_STAGE(PG8_SB(1, 0), b3, voffB);
            PG8_BAR; PG8_WAIT_L(0); PG8_MMA(0, 1, At, B1); PG8_BAR;
            PG8_LDA(At, 1, 1); PG8_STAGE(PG8_SA(1, 0), a3, voffA);
            PG8_BAR; PG8_WAIT_L(0); PG8_MMA(1, 0, At, B0); PG8_BAR; PG8_SCHED;
            PG8_STAGE(PG8_SB(1, 1), b3 + hstep, voffB);
            PG8_WAIT_V(6); PG8_BAR; PG8_MMA(1, 1, At, B1); PG8_BAR;
            }
        }
        if constexpr (ALIGN_EPI) { if (wr == 0) PG8_BAR; }
        if constexpr (!Epi::AFTER_DRAIN) { E(acc, cur, wr, wc, fr, fq); S.done(cur); }
        if (!has_next) break;
#pragma unroll
        for (int a = 0; a < 2; ++a)
#pragma unroll
            for (int b = 0; b < 2; ++b)
#pragma unroll
                for (int m = 0; m < 4; ++m)
#pragma unroll
                    for (int n = 0; n < 2; ++n) acc[a][b][m][n] = (f32x4){0.f, 0.f, 0.f, 0.f};
        cur = nxt; cA = nA; cB = nB; ++ui;
        if constexpr (ALIGN_EPI) { if (wr == 1) PG8_BAR; }
    }
    PG8_WAIT_V(0);
    if constexpr (!ALIGN_EPI) { if (wr == 0) PG8_BAR; }
    PG8_BAR;
    if constexpr (Epi::AFTER_DRAIN) { E.fused(acc, cur, wr, wc, fr, fq, lds, wid, lane); S.done(cur); }
#undef PG8_SA
#undef PG8_SB
#undef PG8_STAGE
#undef PG8_LDA
#undef PG8_LDB
#undef PG8_MMA
#undef PG8_WAIT_V
#undef PG8_WAIT_L
#undef PG8_BAR
#undef PG8_SCHED
}

template <int MODE>
DEV void gemm_run(const Params& p, const bf16_t* A, const bf16_t* Bt, int N, int K, char* smem) {
    Gemm g; g.A = A; g.Bt = Bt; g.M = MTOT; g.N = N; g.K = K;
    Order S; S.init(MTOT, N, gridDim.x, blockIdx.x);
    Epi<MODE> E; E.ob = MODE == 0 ? p.u : p.hid; E.hb = p.hb; E.zx = p.out; E.zm = p.zmeta;
    gemm_phase<Epi<MODE>, Order, true, true>((PG8_LAS unsigned char*)smem, g, S, E);
    __syncthreads();
}

DEV float softplus2(float z) {
    const float e = __builtin_amdgcn_exp2f(-fabsf(z));
    return fmaxf(z, 0.f) + __builtin_amdgcn_logf(1.0f + e);
}

constexpr int KS_STRIDE = 72;
constexpr int VT_STRIDE = 68;

constexpr int VT2_STRIDE = 36;
constexpr float EXIT_THRESH = 80.f;

DEV void attn_tile(const Params& p, int layer, int b, int p0, char* smem) {
    const int tid = tid_(), wid = tid >> 6, lane = tid & 63, ln = lane & 31, hh = lane >> 5;
    const int h = wid;
    bf16_t* Vt = (bf16_t*)smem + wid * (64 * VT2_STRIDE);
    float* ssq = (float*)(smem + 8 * 64 * VT2_STRIDE * 2);
    bf16x8 qf[4];
    {
        const bf16_t* qrow = p.u + (size_t)(b * SEQ + p0 + ln) * DIN + h * 64 + 8 * hh;
#pragma unroll
        for (int s = 0; s < 4; ++s) qf[s] = *(const bf16x8*)(qrow + 16 * s);
    }
    f32x16 o0 = {}, o1 = {};
    float c = 0.f;
    const int kp = lane & 15, dc = lane >> 4;
    uint4 kr[4], vr[4];
    auto load_sub = [&](int st) {
        int rk, rv0;
        if (st >= 0) { rk = b * SEQ + st * 32 + ln; rv0 = b * SEQ + st * 32 + 2 * kp; }
        else { rk = ln < NMETA ? row_of(b, ln) : -1; rv0 = 2 * kp < NMETA ? row_of(b, 2 * kp) : -1; }
        if (rk >= 0) {
            const bf16_t* kptr = p.u + (size_t)rk * DIN + 512 + h * 64 + 8 * hh;
#pragma unroll
            for (int s = 0; s < 4; ++s) kr[s] = *(const uint4*)(kptr + 16 * s);
        } else {
#pragma unroll
            for (int s = 0; s < 4; ++s) kr[s] = make_uint4(0, 0, 0, 0);
        }
        if (rv0 >= 0) {
            const bf16_t* vp = p.u + (size_t)rv0 * DIN + 1024 + h * 64 + 16 * dc;
            vr[0] = *(const uint4*)vp; vr[1] = *(const uint4*)(vp + 8); vr[2] = *(const uint4*)(vp + DIN); vr[3] = *(const uint4*)(vp + DIN + 8);
        } else {
#pragma unroll
            for (int s = 0; s < 4; ++s) vr[s] = make_uint4(0, 0, 0, 0);
        }
    };
    load_sub(p0 >> 5);
    for (int st = p0 >> 5; st >= -1; --st) {
        {
            unsigned* vt = (unsigned*)Vt + (16 * dc) * (VT2_STRIDE / 2) + kp;
            const unsigned a[8] = {vr[0].x, vr[0].y, vr[0].z, vr[0].w, vr[1].x, vr[1].y, vr[1].z, vr[1].w};
            const unsigned bq[8] = {vr[2].x, vr[2].y, vr[2].z, vr[2].w, vr[3].x, vr[3].y, vr[3].z, vr[3].w};
#pragma unroll
            for (int i = 0; i < 8; ++i) {
                vt[(2 * i) * (VT2_STRIDE / 2)] = (a[i] & 0xffffu) | (bq[i] << 16);
                vt[(2 * i + 1) * (VT2_STRIDE / 2)] = (a[i] >> 16) | (bq[i] & 0xffff0000u);
            }
        }
        union { uint4 u; bf16x8 v; } kf[4];
#pragma unroll
        for (int s = 0; s < 4; ++s) kf[s].u = kr[s];
        if (st > -1) load_sub(st - 1);
        __builtin_amdgcn_wave_barrier();
        f32x16 z = {};
#pragma unroll
        for (int s = 0; s < 4; ++s) z = __builtin_amdgcn_mfma_f32_32x32x16_bf16(kf[s].v, qf[s], z, 0, 0, 0);
        const bool masked = (st < 0) || (st * 32 == p0);
        const int lim = st < 0 ? NMETA : ln;
        float sp[16];
        if (masked) {
#pragma unroll
            for (int r = 0; r < 16; ++r) { const int kk = 8 * (r >> 2) + 4 * hh + (r & 3); sp[r] = kk < lim ? softplus2(z[r]) : 0.f; }
        } else {
#pragma unroll
            for (int r = 0; r < 16; ++r) sp[r] = softplus2(z[r]);
        }
        float G[4], PG[4];
#pragma unroll
        for (int j = 0; j < 4; ++j) { G[j] = (sp[4 * j] + sp[4 * j + 1]) + (sp[4 * j + 2] + sp[4 * j + 3]); PG[j] = __shfl_xor(G[j], 32); }
        float stt = 0.f, a[16];
#pragma unroll
        for (int j = 3; j >= 0; --j) {
            float run = stt + c + (hh == 0 ? PG[j] : 0.f);
#pragma unroll
            for (int i = 3; i >= 0; --i) {
                const int r = 4 * j + i;
                run += sp[r];
                a[r] = __builtin_amdgcn_exp2f(z[r] - run);
            }
            stt += G[j] + PG[j];
        }
        if (masked) {
#pragma unroll
            for (int r = 0; r < 16; ++r) { const int kk = 8 * (r >> 2) + 4 * hh + (r & 3); a[r] = kk < lim ? a[r] : 0.f; }
        }
        c += stt;
#pragma unroll
        for (int m = 0; m < 2; ++m) {
            union { bf16x8 v; unsigned w[4]; } af;
            af.w[0] = pk_bf16(a[8 * m + 0], a[8 * m + 1]); af.w[1] = pk_bf16(a[8 * m + 2], a[8 * m + 3]);
            af.w[2] = pk_bf16(a[8 * m + 4], a[8 * m + 5]); af.w[3] = pk_bf16(a[8 * m + 6], a[8 * m + 7]);
            union { bf16x8 v; uint2 d[2]; } v0, v1;
            const bf16_t* vb = Vt + ln * VT2_STRIDE + 16 * m + 4 * hh;
            v0.d[0] = *(const uint2*)vb; v0.d[1] = *(const uint2*)(vb + 8);
            v1.d[0] = *(const uint2*)(vb + 32 * VT2_STRIDE); v1.d[1] = *(const uint2*)(vb + 32 * VT2_STRIDE + 8);
            o0 = __builtin_amdgcn_mfma_f32_32x32x16_bf16(v0.v, af.v, o0, 0, 0, 0);
            o1 = __builtin_amdgcn_mfma_f32_32x32x16_bf16(v1.v, af.v, o1, 0, 0, 0);
        }
        __builtin_amdgcn_wave_barrier();
        if (__ballot(c < EXIT_THRESH) == 0) break;
    }
    {
        float ss = 0.f;
#pragma unroll
        for (int r = 0; r < 16; ++r) ss += o0[r] * o0[r] + o1[r] * o1[r];
        ss += __shfl_xor(ss, 32);
        if (hh == 0) ssq[wid * 32 + ln] = ss;
        __syncthreads();
        float tot = 0.f;
#pragma unroll
        for (int w = 0; w < 8; ++w) tot += ssq[w * 32 + ln];
        const float rn = rsqrtf(tot * (1.0f / 512.0f) + 1e-6f);
        const float* g = p.g_mix + (size_t)layer * D + h * 64 + 4 * hh;
        bf16_t* orow = p.y + (size_t)(b * SEQ + p0 + ln) * D + h * 64 + 4 * hh;
#pragma unroll
        for (int j = 0; j < 4; ++j) {
            const float4 g0 = *(const float4*)(g + 8 * j), g1 = *(const float4*)(g + 32 + 8 * j);
            uint2 w; w.x = pk_bf16(o0[4 * j] * rn * g0.x, o0[4 * j + 1] * rn * g0.y); w.y = pk_bf16(o0[4 * j + 2] * rn * g0.z, o0[4 * j + 3] * rn * g0.w);
            *(uint2*)(orow + 8 * j) = w;
            w.x = pk_bf16(o1[4 * j] * rn * g1.x, o1[4 * j + 1] * rn * g1.y); w.y = pk_bf16(o1[4 * j + 2] * rn * g1.z, o1[4 * j + 3] * rn * g1.w);
            *(uint2*)(orow + 32 + 8 * j) = w;
        }
    }
    __syncthreads();
}

DEV void attn_meta_unit(const Params& p, int b, int h, char* smem) {
    float* qs = (float*)smem;
    float* ks = qs + 1024;
    float* vs = ks + 16 * 65;
    float* zs = vs + 1024;
    const int tid = tid_();
    for (int i = tid; i < 16 * 64; i += NTHREADS) {
        const int t = i >> 6, d = i & 63;
        const bf16_t* r = p.u + (size_t)(MX + b * NMETA + t) * DIN + h * 64 + d;
        qs[t * 64 + d] = __uint_as_float((unsigned)r[0] << 16);
        ks[t * 65 + d] = __uint_as_float((unsigned)r[512] << 16);
        vs[t * 64 + d] = __uint_as_float((unsigned)r[1024] << 16);
    }
    __syncthreads();
    if (tid < 256) {
        const int t = tid >> 4, s = tid & 15;
        float acc = 0.f;
        for (int d = 0; d < 64; ++d) acc += qs[t * 64 + d] * ks[s * 65 + d];
        zs[tid] = acc;
    }
    __syncthreads();
    {
        const int t = tid >> 5, d0 = (tid & 31) * 2;
        float c = 0.f, oa = 0.f, ob = 0.f;
        for (int s = t - 1; s >= 0; --s) {
            const float z = zs[t * 16 + s];
            c += softplus2(z);
            const float a = __builtin_amdgcn_exp2f(z - c);
            oa += a * vs[s * 64 + d0]; ob += a * vs[s * 64 + d0 + 1];
        }
        *(unsigned*)(p.y + (size_t)(MX + b * NMETA + t) * D + h * 64 + d0) = pk_bf16(oa, ob);
    }
    __syncthreads();
}

DEV float sigmoidf_(float v) { return 1.0f / (1.0f + __expf(-v)); }

DEV void post_unit(const Params& p, int layer, int b, int q0, int T, bool norm_attn, char* smem) {
    float* hc = (float*)smem;
    float* cv = hc + 62 * 256;
    const int tid = tid_(), wid = tid >> 6, lane = tid & 63;
    for (int i = tid; i < 62 * 32; i += NTHREADS) {
        const int r = i >> 5, c8 = (i & 31) * 8;
        const int q = q0 - 30 + r;
        float o[8];
        if (q >= 0 && r < T + 30) {
            const bf16_t* src = p.u + (size_t)row_of(b, q) * DIN + 1536 + c8;
            const uint4 a = *(const uint4*)src, g = *(const uint4*)(src + 256);
            o[0] = bflo(a.x) * sigmoidf_(bflo(g.x)); o[1] = bfhi(a.x) * sigmoidf_(bfhi(g.x));
            o[2] = bflo(a.y) * sigmoidf_(bflo(g.y)); o[3] = bfhi(a.y) * sigmoidf_(bfhi(g.y));
            o[4] = bflo(a.z) * sigmoidf_(bflo(g.z)); o[5] = bfhi(a.z) * sigmoidf_(bfhi(g.z));
            o[6] = bflo(a.w) * sigmoidf_(bflo(g.w)); o[7] = bfhi(a.w) * sigmoidf_(bfhi(g.w));
        } else {
#pragma unroll
            for (int k = 0; k < 8; ++k) o[k] = 0.f;
        }
        *(float4*)(hc + r * 256 + c8) = make_float4(o[0], o[1], o[2], o[3]);
        *(float4*)(hc + r * 256 + c8 + 4) = make_float4(o[4], o[5], o[6], o[7]);
    }
    __syncthreads();
    {
        const int ch = tid & 255, half = tid >> 8;
        const float* wdw = p.w_conf_dw + (size_t)layer * 31 * 256 + ch;
        float w[31];
#pragma unroll
        for (int k = 0; k < 31; ++k) w[k] = wdw[k * 256];
        const float bias = p.b_conf_dw[layer * 256 + ch];
        float acc[16];
#pragma unroll
        for (int i = 0; i < 16; ++i) acc[i] = bias;
        const float* src = hc + (half * 16) * 256 + ch;
#pragma unroll
        for (int j = 0; j < 46; ++j) {
            const float v = src[j * 256];
#pragma unroll
            for (int i = 0; i < 16; ++i) if (j - i >= 0 && j - i <= 30) acc[i] += w[j - i] * v;
        }
#pragma unroll
        for (int i = 0; i < 16; ++i) cv[(half * 16 + i) * 256 + ch] = acc[i];
    }
    __syncthreads();
    const float* gmix = p.g_mix + (size_t)layer * D;
    for (int i = wid; i < T; i += 8) {
        const int q = q0 + i, row = row_of(b, q);
        bf16_t* yrow = p.y + (size_t)row * D;
        {
            const int c0 = lane * 4;
            const float4 v = *(const float4*)(cv + i * 256 + c0);
            const float mu = wave_sum((v.x + v.y) + (v.z + v.w)) * (1.0f / 256.0f);
            const float dx = v.x - mu, dy = v.y - mu, dz = v.z - mu, dw = v.w - mu;
            const float rstd = rsqrtf(wave_sum((dx * dx + dy * dy) + (dz * dz + dw * dw)) * (1.0f / 256.0f) + 1e-5f);
            const float4 g = *(const float4*)(p.ln_conf_g + layer * 256 + c0), bb = *(const float4*)(p.ln_conf_b + layer * 256 + c0);
            float t0 = dx * rstd * g.x + bb.x, t1 = dy * rstd * g.y + bb.y, t2 = dz * rstd * g.z + bb.z, t3 = dw * rstd * g.w + bb.w;
            t0 *= sigmoidf_(t0); t1 *= sigmoidf_(t1); t2 *= sigmoidf_(t2); t3 *= sigmoidf_(t3);
            const float r = rsqrtf(wave_sum((t0 * t0 + t1 * t1) + (t2 * t2 + t3 * t3)) * (1.0f / 256.0f) + 1e-6f);
            const float4 gm = *(const float4*)(gmix + 512 + c0);
            uint2 w; w.x = pk_bf16(t0 * r * gm.x, t1 * r * gm.y); w.y = pk_bf16(t2 * r * gm.z, t3 * r * gm.w);
            *(uint2*)(yrow + 512 + c0) = w;
        }
        {
            const int c0 = lane * 4;
            float s0 = 0.f, s1 = 0.f, s2 = 0.f, s3 = 0.f;
#pragma unroll
            for (int k = 0; k < 3; ++k) {
                const int qq = q - 2 + k;
                if (qq >= 0) {
                    const bf16_t* src = p.u + (size_t)row_of(b, qq) * DIN + 2304 + c0;
                    const uint2 cg_ = *(const uint2*)src, hv = *(const uint2*)(src + 256);
                    const float4 wk = *(const float4*)(p.w_short_dw + (size_t)layer * 3 * 256 + k * 256 + c0);
                    s0 += wk.x * bflo(cg_.x) * bflo(hv.x); s1 += wk.y * bfhi(cg_.x) * bfhi(hv.x);
                    s2 += wk.z * bflo(cg_.y) * bflo(hv.y); s3 += wk.w * bfhi(cg_.y) * bfhi(hv.y);
                }
            }
            const uint2 bg = *(const uint2*)(p.u + (size_t)row * DIN + 2048 + c0);
            s0 *= bflo(bg.x); s1 *= bfhi(bg.x); s2 *= bflo(bg.y); s3 *= bfhi(bg.y);
            const float r = rsqrtf(wave_sum((s0 * s0 + s1 * s1) + (s2 * s2 + s3 * s3)) * (1.0f / 256.0f) + 1e-6f);
            const float4 gm = *(const float4*)(gmix + 768 + c0);
            uint2 w; w.x = pk_bf16(s0 * r * gm.x, s1 * r * gm.y); w.y = pk_bf16(s2 * r * gm.z, s3 * r * gm.w);
            *(uint2*)(yrow + 768 + c0) = w;
        }
        if (norm_attn) {
            const int c0 = lane * 8;
            const uint4 ov = *(const uint4*)(yrow + c0);
            float f[8] = {bflo(ov.x), bfhi(ov.x), bflo(ov.y), bfhi(ov.y), bflo(ov.z), bfhi(ov.z), bflo(ov.w), bfhi(ov.w)};
            float ss = 0.f;
#pragma unroll
            for (int k = 0; k < 8; ++k) ss += f[k] * f[k];
            const float r = rsqrtf(wave_sum(ss) * (1.0f / 512.0f) + 1e-6f);
            const float4 g0 = *(const float4*)(gmix + c0), g1 = *(const float4*)(gmix + c0 + 4);
            uint4 w;
            w.x = pk_bf16(f[0] * r * g0.x, f[1] * r * g0.y); w.y = pk_bf16(f[2] * r * g0.z, f[3] * r * g0.w);
            w.z = pk_bf16(f[4] * r * g1.x, f[5] * r * g1.y); w.w = pk_bf16(f[6] * r * g1.z, f[7] * r * g1.w);
            *(uint4*)(yrow + c0) = w;
        }
    }
    __syncthreads();
}

DEV void mixer_phase(const Params& p, int layer, char* smem) {
    const int nx = NB * (SEQ / 32), ntot = nx + NB;
    for (int u = blockIdx.x; u < ntot; u += gridDim.x) {
        if (u < nx) {
            const int b = u / (SEQ / 32), p0 = (u % (SEQ / 32)) * 32;
            attn_tile(p, layer, b, p0, smem);
            post_unit(p, layer, b, NMETA + p0, 32, false, smem);
        } else {
            const int b = u - nx;
            for (int h = 0; h < 8; ++h) attn_meta_unit(p, b, h, smem);
            post_unit(p, layer, b, 0, NMETA, true, smem);
        }
    }
}

constexpr int NPHASE = 1 + DEPTH * 7;

DEV void run_phase(const Params& p, int ph, char* smem) {
#ifdef TESTP
    const int l = (ph - 1) / 7, s = TESTP;
    if (TESTP == 8) { prologue_phase(p, smem); return; }
#else
    if (ph == 0) { prologue_phase(p, smem); return; }
    const int l = (ph - 1) / 7, s = (ph - 1) % 7;
#endif
    switch (s) {
        case 0: gemm_run<0>(p, p.hb, p.wt_in + (size_t)l * D * DIN, DIN, D, smem); break;
        case 1: mixer_phase(p, l, smem); break;
        case 2: gemm_run<2>(p, p.y, p.wt_out + (size_t)l * D * D, D, D, smem); break;
        case 3: ln_phase(p, p.ln_mix_g + l * D, p.ln_mix_b + l * D, false); break;
        case 4: gemm_run<1>(p, p.hb, p.wt_ff1 + (size_t)l * D * DFF, DFF, D, smem); break;
        case 5: gemm_run<2>(p, p.hid, p.wt_ff2 + (size_t)l * D * DFF, D, DFF, smem); break;
        default: ln_phase(p, p.ln_ff_g + l * D, p.ln_ff_b + l * D, l == DEPTH - 1); break;
    }
}

__global__ void __launch_bounds__(NTHREADS, 2) mega(Params p, int ph_begin, int ph_end) {
    extern __shared__ __attribute__((aligned(16))) char smem[];
    cg::grid_group grid = cg::this_grid();
    for (int ph = ph_begin; ph < ph_end; ++ph) {
        run_phase(p, ph, smem);
        if (ph + 1 < ph_end) grid.sync();
    }
}

extern "C" void kernel_launch(void* const* d_in, const int* in_sizes, int n_in, void* d_out, int out_size, void* d_ws, size_t ws_size,
                              hipStream_t stream) {
    static int grid_blocks = 0;
    if (!grid_blocks) {
        int dev = 0, cus = 0, per_cu = 0;
        hipGetDevice(&dev);
        hipDeviceGetAttribute(&cus, hipDeviceAttributeMultiprocessorCount, dev);
        hipFuncSetAttribute((const void*)mega, hipFuncAttributeMaxDynamicSharedMemorySize, LDS_BYTES);
        hipOccupancyMaxActiveBlocksPerMultiprocessor(&per_cu, mega, NTHREADS, LDS_BYTES);
        if (per_cu < 1) per_cu = 1;
        grid_blocks = cus * (per_cu > 1 ? 1 : per_cu);
    }
    Params p{};
    const float* const* in = (const float* const*)d_in;
    p.x = in[0]; p.meta = in[1]; p.ln_in_g = in[2]; p.ln_in_b = in[3]; p.w_in = in[4]; p.w_conf_dw = in[5]; p.b_conf_dw = in[6];
    p.ln_conf_g = in[7]; p.ln_conf_b = in[8]; p.w_short_dw = in[9]; p.g_mix = in[10]; p.w_out = in[11]; p.ln_mix_g = in[12];
    p.ln_mix_b = in[13]; p.w_ff1 = in[14]; p.w_ff2 = in[15]; p.ln_ff_g = in[16]; p.ln_ff_b = in[17];
    p.out = (float*)d_out;
    char* ws = (char*)d_ws;
    size_t off = 0;
    auto take = [&](size_t bytes) { char* r = ws + off; off += (bytes + 255) & ~(size_t)255; return r; };
    p.wt_in = (bf16_t*)take((size_t)DEPTH * D * DIN * 2);
    p.wt_out = (bf16_t*)take((size_t)DEPTH * D * D * 2);
    p.wt_ff1 = (bf16_t*)take((size_t)DEPTH * D * DFF * 2);
    p.wt_ff2 = (bf16_t*)take((size_t)DEPTH * D * DFF * 2);
    p.hb = (bf16_t*)take((size_t)MTOT * D * 2);
    p.zmeta = (float*)take((size_t)NB * NMETA * D * 4);
    p.hid = (bf16_t*)take((size_t)MTOT * DFF * 2);
    p.u = p.hid;
    p.y = p.hid + (size_t)MTOT * DIN;
    if (off > ws_size) { fprintf(stderr, "workspace too small: need %zu have %zu\n", off, ws_size); return; }
#if ONE_LAUNCH
    int b = 0, e = NPHASE;
    void* args[] = {&p, &b, &e};
    hipError_t err = hipLaunchCooperativeKernel((const void*)mega, dim3(grid_blocks), dim3(NTHREADS), args, LDS_BYTES, stream);
    if (err != hipSuccess) fprintf(stderr, "cooperative launch failed: %s (grid %d)\n", hipGetErrorString(err), grid_blocks);
#else
    for (int ph = 0; ph < NPHASE; ++ph) {
        int b = ph, e = ph + 1;
        void* args[] = {&p, &b, &e};
        hipError_t err = hipLaunchCooperativeKernel((const void*)mega, dim3(grid_blocks), dim3(NTHREADS), args, LDS_BYTES, stream);
        if (err != hipSuccess) fprintf(stderr, "launch failed: %s\n", hipGetErrorString(err));
    }
#endif
}
```

```cpp
#include <hip/hip_runtime.h>
#include <hip/hip_cooperative_groups.h>
#include <cstdint>
#include <cstdio>
namespace cg = cooperative_groups;

#ifndef ONE_LAUNCH
#define ONE_LAUNCH 1
#endif

#define DEV __device__ __forceinline__
__device__ __forceinline__ int tid_() { int t = threadIdx.x; asm volatile("" : "+v"(t)); return t; }
typedef unsigned short bf16_t;
typedef short bf16x8 __attribute__((ext_vector_type(8)));
typedef float f32x4 __attribute__((ext_vector_type(4)));
typedef float f32x16 __attribute__((ext_vector_type(16)));

constexpr int D = 1024, NB = 16, SEQ = 2048, NMETA = 16;
constexpr int MX = NB * SEQ;
constexpr int MTOT = MX + NMETA;
constexpr int DIN = 2816, DFF = 4096, DEPTH = 4;
constexpr float ALPHA = 1.681792830507429f;
constexpr float QSCALE = 0.125f * 1.4426950408889634f;
constexpr int NTHREADS = 512;
constexpr int LDS_BYTES = 131072;

struct Params {
    const float *x, *meta, *ln_in_g, *ln_in_b, *w_in, *w_conf_dw, *b_conf_dw, *ln_conf_g, *ln_conf_b, *w_short_dw, *g_mix,
        *w_out, *ln_mix_g, *ln_mix_b, *w_ff1, *w_ff2, *ln_ff_g, *ln_ff_b;
    float* out;
    bf16_t *wt_in, *wt_out, *wt_ff1, *wt_ff2, *hb, *u, *y, *hid;
    float* zmeta;
};

DEV unsigned pk_bf16(float lo, float hi) { unsigned r; asm("v_cvt_pk_bf16_f32 %0, %1, %2" : "=v"(r) : "v"(lo), "v"(hi)); return r; }
DEV float bflo(unsigned w) { return __uint_as_float(w << 16); }
DEV float bfhi(unsigned w) { return __uint_as_float(w & 0xffff0000u); }
DEV float wave_sum(float v) {
#pragma unroll
    for (int o = 32; o >= 1; o >>= 1) v += __shfl_xor(v, o);
    return v;
}
DEV float* zrow(const Params& p, int row) { return row < MX ? p.out + (size_t)row * D : p.zmeta + (size_t)(row - MX) * D; }
DEV int row_of(int b, int q) { return q < NMETA ? MX + q : b * SEQ + (q - NMETA); }

DEV void transpose_unit(const float* __restrict__ W, bf16_t* __restrict__ Wt, int K, int N, int kt, int nt, float* tile) {
    const int tid = tid_();
    {
        const int kr = tid >> 3, nc = (tid & 7) * 8;
        const float* src = W + (size_t)(kt * 64 + kr) * N + nt * 64 + nc;
        const float4 a = *(const float4*)src, b = *(const float4*)(src + 4);
        float* t = tile + kr * 65 + nc;
        t[0] = a.x; t[1] = a.y; t[2] = a.z; t[3] = a.w; t[4] = b.x; t[5] = b.y; t[6] = b.z; t[7] = b.w;
    }
    __syncthreads();
    {
        const int n = tid >> 3, kc = (tid & 7) * 8;
        const float* t = tile + kc * 65 + n;
        uint4 w;
        w.x = pk_bf16(t[0], t[65]); w.y = pk_bf16(t[130], t[195]); w.z = pk_bf16(t[260], t[325]); w.w = pk_bf16(t[390], t[455]);
        *(uint4*)(Wt + (size_t)(nt * 64 + n) * K + kt * 64 + kc) = w;
    }
    __syncthreads();
}

DEV void ln_row_store(const float4 (&v)[4], const float* __restrict__ g, const float* __restrict__ b, bf16_t* dst, float* dstf, int lane) {
    float s = 0.f;
#pragma unroll
    for (int i = 0; i < 4; ++i) s += (v[i].x + v[i].y) + (v[i].z + v[i].w);
    const float mu = wave_sum(s) * (1.0f / D);
    float q = 0.f;
#pragma unroll
    for (int i = 0; i < 4; ++i) { const float a = v[i].x - mu, bb = v[i].y - mu, c = v[i].z - mu, d = v[i].w - mu; q += (a * a + bb * bb) + (c * c + d * d); }
    const float rstd = rsqrtf(wave_sum(q) * (1.0f / D) + 1e-5f);
#pragma unroll
    for (int i = 0; i < 4; ++i) {
        const int col = lane * 4 + 256 * i;
        const float4 gg = *(const float4*)(g + col), bb = *(const float4*)(b + col);
        float4 o;
        o.x = (v[i].x - mu) * rstd * gg.x + bb.x; o.y = (v[i].y - mu) * rstd * gg.y + bb.y;
        o.z = (v[i].z - mu) * rstd * gg.z + bb.z; o.w = (v[i].w - mu) * rstd * gg.w + bb.w;
        if (dst) { uint2 w; w.x = pk_bf16(o.x, o.y); w.y = pk_bf16(o.z, o.w); *(uint2*)(dst + col) = w; }
        if (dstf) *(float4*)(dstf + col) = o;
    }
}

DEV void prologue_phase(const Params& p, char* smem) {
    float* tile = (float*)smem;
    const int n_in = 16 * 44, n_out = 16 * 16, n_f1 = 16 * 64, n_f2 = 64 * 16;
    const int per_layer = n_in + n_out + n_f1 + n_f2;
    for (int u = blockIdx.x; u < per_layer * DEPTH; u += gridDim.x) {
        const int l = u / per_layer; int r = u % per_layer;
        if (r < n_in) { transpose_unit(p.w_in + (size_t)l * D * DIN, p.wt_in + (size_t)l * D * DIN, D, DIN, r / 44, r % 44, tile); continue; }
        r -= n_in;
        if (r < n_out) { transpose_unit(p.w_out + (size_t)l * D * D, p.wt_out + (size_t)l * D * D, D, D, r / 16, r % 16, tile); continue; }
        r -= n_out;
        if (r < n_f1) { transpose_unit(p.w_ff1 + (size_t)l * D * DFF, p.wt_ff1 + (size_t)l * D * DFF, D, DFF, r / 64, r % 64, tile); continue; }
        r -= n_f1;
        transpose_unit(p.w_ff2 + (size_t)l * D * DFF, p.wt_ff2 + (size_t)l * D * DFF, DFF, D, r / 16, r % 16, tile);
    }
    const int tid = tid_(), wid = tid >> 6, lane = tid & 63;
    for (int row = blockIdx.x * 8 + wid; row < MTOT; row += gridDim.x * 8) {
        const float* src = row < MX ? p.x + (size_t)row * D : p.meta + (size_t)(row - MX) * D;
        float4 v[4];
#pragma unroll
        for (int i = 0; i < 4; ++i) v[i] = *(const float4*)(src + lane * 4 + 256 * i);
        ln_row_store(v, p.ln_in_g, p.ln_in_b, p.hb + (size_t)row * D, nullptr, lane);
    }
}

DEV void ln_phase(const Params& p, const float* g, const float* b, bool final) {
    const int tid = tid_(), wid = tid >> 6, lane = tid & 63;
    for (int row = blockIdx.x * 8 + wid; row < MTOT; row += gridDim.x * 8) {
        float* src = zrow(p, row);
        float4 v[4];
#pragma unroll
        for (int i = 0; i < 4; ++i) v[i] = *(const float4*)(src + lane * 4 + 256 * i);
        if (final) { if (row < MX) ln_row_store(v, g, b, nullptr, src, lane); }
        else ln_row_store(v, g, b, p.hb + (size_t)row * D, nullptr, lane);
    }
}

#define PG8_LAS __attribute__((address_space(3)))
constexpr int BM = 256, BK = 64, HALF = 128, HTB = HALF * BK * 2, STAGE_BYTES = 8 * HTB;
DEV int lds_byte(int r, int c) { const int st = (r >> 4) * 2 + (c >> 5), rr = r & 15, cc = c & 31, ob = rr * 64 + cc * 2; return st * 1024 + (ob ^ (((ob >> 9) & 1) << 5)); }
DEV void stage_rc(int b, int& R, int& C) { const int st = b / 1024, sb = b % 1024, swz = sb ^ (((sb >> 9) & 1) << 5); R = (st >> 1) * 16 + swz / 64; C = (st & 1) * 32 + (swz % 64) / 2; }
DEV int perm32(int rho) { const int n = rho >> 4, i = rho & 15; return 8 * (i >> 2) + 4 * n + (i & 3); }
struct Unit { int pm, pn; };
struct Gemm { const bf16_t* A; const bf16_t* Bt; int M, N, K; };

struct Order {
    int nM, nN, nwg, G, c;
    DEV void init(int M, int N, int G_, int c_) { nM = M / BM; nN = N / BM; nwg = nM * nN; G = G_; c = c_; }
    DEV bool next(int i, Unit& u) const {
        const int L = i * G + c; if (L >= nwg) return false;
        const int nig = 8 * nN, gid = L / nig, fm = gid * 8, gsz = (nM - fm) < 8 ? (nM - fm) : 8;
        u.pm = fm + ((L % nig) % gsz); u.pn = (L % nig) / gsz; return true;
    }
    DEV void a_ready(const Unit&) const {}
    DEV void done(const Unit&) const {}
};

template <int MODE> struct Epi {
    static constexpr bool PERM = true, AFTER_DRAIN = false;
    bf16_t* ob;
    const bf16_t* hb;
    float* zx; float* zm;
    DEV void operator()(const f32x4 (&acc)[2][2][4][2], const Unit& u, int wr, int wc, int fr, int fq) const {
        const int row0 = u.pm * BM + wr * 64 + fr, col0 = u.pn * BM + wc * 32 + 8 * fq;
#pragma unroll
        for (int ai = 0; ai < 2; ++ai)
#pragma unroll
            for (int m = 0; m < 4; ++m) {
                const int row = row0 + ai * HALF + m * 16;
#pragma unroll
                for (int bj = 0; bj < 2; ++bj) {
                    const int col = col0 + bj * HALF;
                    f32x4 v0 = acc[ai][bj][m][0], v1 = acc[ai][bj][m][1];
                    if (MODE == 0) {
                        if (col < 512) { v0 = v0 * QSCALE; v1 = v1 * QSCALE; }
                        uint4 w; w.x = pk_bf16(v0[0], v0[1]); w.y = pk_bf16(v0[2], v0[3]); w.z = pk_bf16(v1[0], v1[1]); w.w = pk_bf16(v1[2], v1[3]);
                        *(uint4*)(ob + (size_t)row * DIN + col) = w;
                    } else if (MODE == 1) {
#pragma unroll
                        for (int k = 0; k < 4; ++k) { v0[k] = fmaxf(v0[k], 0.f); v1[k] = fmaxf(v1[k], 0.f); }
                        v0 = v0 * v0; v1 = v1 * v1;
                        uint4 w; w.x = pk_bf16(v0[0], v0[1]); w.y = pk_bf16(v0[2], v0[3]); w.z = pk_bf16(v1[0], v1[1]); w.w = pk_bf16(v1[2], v1[3]);
                        *(uint4*)(ob + (size_t)row * DFF + col) = w;
                    } else {
                        const uint4 hw = *(const uint4*)(hb + (size_t)row * D + col);
                        f32x4 o0, o1;
                        o0[0] = ALPHA * bflo(hw.x) + v0[0]; o0[1] = ALPHA * bfhi(hw.x) + v0[1]; o0[2] = ALPHA * bflo(hw.y) + v0[2]; o0[3] = ALPHA * bfhi(hw.y) + v0[3];
                        o1[0] = ALPHA * bflo(hw.z) + v1[0]; o1[1] = ALPHA * bfhi(hw.z) + v1[1]; o1[2] = ALPHA * bflo(hw.w) + v1[2]; o1[3] = ALPHA * bfhi(hw.w) + v1[3];
                        float* zr = (row < MX ? zx + (size_t)row * D : zm + (size_t)(row - MX) * D) + col;
                        *(f32x4*)zr = o0; *(f32x4*)(zr + 4) = o1;
                    }
                }
            }
    }
};

template <class Epi, class Sched, bool ALIGN_EPI = false, bool SP2 = false>
__device__ __forceinline__ void gemm_phase(PG8_LAS unsigned char* lds, const Gemm g, const Sched& S, const Epi& E) {
    const int tid = tid_(), wid = __builtin_amdgcn_readfirstlane(tid >> 6), lane = tid & 63, wr = wid >> 2, wc = wid & 3, fr = lane & 15, fq = lane >> 4;
    const int K = g.K, nt = K / BK;
    unsigned voffA[2], voffB[2];
#pragma unroll
    for (int i = 0; i < 2; ++i) { int R, C; stage_rc(tid * 16 + i * 8192, R, C); const int Rb = Epi::PERM ? ((R & ~31) + perm32(R & 31)) : R;
        voffA[i] = (unsigned)(R * K + C) * 2u; voffB[i] = (unsigned)(Rb * K + C) * 2u; }
    const size_t kstep = (size_t)(BK * 2);
    const size_t hstep = (size_t)HALF * K * 2;
    const size_t tstep = 2 * hstep;
    const unsigned ldsw = (unsigned)wid * 1024u;
    const int aoff = lds_byte(wr * 64 + fr, fq * 8), boff = lds_byte(wc * 32 + fr, fq * 8);
#define PG8_SA(b, h) (((b) * 2 + (h)) * HTB)
#define PG8_SB(b, h) ((4 + (b) * 2 + (h)) * HTB)
#define PG8_STAGE(bufoff, gbase, voff) do { _Pragma("unroll") for (int _i = 0; _i < 2; ++_i) \
        __builtin_amdgcn_global_load_lds((const unsigned*)((const char*)(gbase) + (voff)[_i]), (PG8_LAS unsigned*)(lds + (bufoff) + ldsw + _i * 8192), 16, 0, 0); } while (0)
#define PG8_LDA(dst, b, h) do { _Pragma("unroll") for (int m = 0; m < 4; ++m) _Pragma("unroll") for (int k = 0; k < 2; ++k) dst[m][k] = *(const PG8_LAS bf16x8*)(lds + PG8_SA(b, h) + aoff + m * 2048 + k * 1024); } while (0)
#define PG8_LDB(dst, b, h) do { _Pragma("unroll") for (int n = 0; n < 2; ++n) _Pragma("unroll") for (int k = 0; k < 2; ++k) dst[n][k] = *(const PG8_LAS bf16x8*)(lds + PG8_SB(b, h) + boff + n * 2048 + k * 1024); } while (0)
#define PG8_MMA(ai, bj, At, Bt) do { __builtin_amdgcn_s_setprio(1); _Pragma("unroll") for (int m = 0; m < 4; ++m) _Pragma("unroll") for (int n = 0; n < 2; ++n) _Pragma("unroll") for (int k = 0; k < 2; ++k) \
        acc[ai][bj][m][n] = __builtin_amdgcn_mfma_f32_16x16x32_bf16(Bt[n][k], At[m][k], acc[ai][bj][m][n], 0, 0, 0); __builtin_amdgcn_s_setprio(0); } while (0)
#define PG8_WAIT_V(n) asm volatile("s_waitcnt vmcnt(" #n ")" ::: "memory")
#define PG8_WAIT_L(n) asm volatile("s_waitcnt lgkmcnt(" #n ")" ::: "memory")
#define PG8_BAR __builtin_amdgcn_s_barrier()
#define PG8_SCHED __builtin_amdgcn_sched_barrier(0)
    Unit cur, nxt; int ui = 0;
    if (!S.next(0, cur)) return;
    f32x4 acc[2][2][4][2];
#pragma unroll
    for (int a = 0; a < 2; ++a)
#pragma unroll
        for (int b = 0; b < 2; ++b)
#pragma unroll
            for (int m = 0; m < 4; ++m)
#pragma unroll
                for (int n = 0; n < 2; ++n) acc[a][b][m][n] = (f32x4){0.f, 0.f, 0.f, 0.f};
    bf16x8 At[4][2], B0[2][2], B1[2][2];
    const char* cA = (const char*)g.A + (size_t)cur.pm * tstep; const char* cB = (const char*)g.Bt + (size_t)cur.pn * tstep;
    S.a_ready(cur);
    if constexpr (SP2) {
        PG8_STAGE(PG8_SB(0, 0), cB, voffB); PG8_STAGE(PG8_SB(0, 1), cB + hstep, voffB); PG8_STAGE(PG8_SA(0, 0), cA, voffA); PG8_STAGE(PG8_SA(0, 1), cA + hstep, voffA);
        if (wr == 1) PG8_BAR;
        PG8_WAIT_V(2); PG8_BAR;
        PG8_STAGE(PG8_SB(1, 0), cB + kstep, voffB); PG8_STAGE(PG8_SA(1, 0), cA + kstep, voffA); PG8_STAGE(PG8_SB(1, 1), cB + hstep + kstep, voffB);
        PG8_WAIT_V(6); PG8_BAR;
    } else {
        PG8_STAGE(PG8_SB(0, 0), cB, voffB); PG8_STAGE(PG8_SA(0, 0), cA, voffA); PG8_STAGE(PG8_SB(0, 1), cB + hstep, voffB); PG8_STAGE(PG8_SA(0, 1), cA + hstep, voffA);
        if (wr == 1) PG8_BAR;
        PG8_WAIT_V(4); PG8_BAR;
        PG8_STAGE(PG8_SB(1, 0), cB + kstep, voffB); PG8_STAGE(PG8_SA(1, 0), cA + kstep, voffA); PG8_STAGE(PG8_SB(1, 1), cB + hstep + kstep, voffB);
        PG8_WAIT_V(6); PG8_BAR;
    }
    for (;;) {
        const bool has_next = S.next(ui + 1, nxt);
        const char* nA = has_next ? (const char*)g.A + (size_t)nxt.pm * tstep : cA; const char* nB = has_next ? (const char*)g.Bt + (size_t)nxt.pn * tstep : cB;
        for (int t = 0; t < nt; t += 2) {
            const bool last = (t == nt - 2);
            const char* a1 = cA + (size_t)(t + 1) * kstep;
            const char* a2 = last ? nA : cA + (size_t)(t + 2) * kstep; const char* b2 = last ? nB : cB + (size_t)(t + 2) * kstep;
            const char* a3 = a2 + kstep; const char* b3 = b2 + kstep;
            if (last && has_next) S.a_ready(nxt);
            if constexpr (SP2) {
            PG8_LDB(B0, 0, 0); PG8_LDB(B1, 0, 1); PG8_SCHED; PG8_LDA(At, 0, 0); PG8_STAGE(PG8_SA(1, 1), a1 + hstep, voffA);
            PG8_WAIT_V(8); PG8_WAIT_L(0); PG8_BAR; PG8_MMA(0, 0, At, B0); PG8_MMA(0, 1, At, B1); PG8_BAR; PG8_SCHED;
            PG8_LDA(At, 0, 1); PG8_STAGE(PG8_SB(0, 0), b2, voffB); PG8_STAGE(PG8_SB(0, 1), b2 + hstep, voffB); PG8_STAGE(PG8_SA(0, 0), a2, voffA);
            PG8_WAIT_V(8); PG8_WAIT_L(0); PG8_BAR; PG8_MMA(1, 0, At, B0); PG8_MMA(1, 1, At, B1); PG8_BAR; PG8_SCHED;
            PG8_LDB(B0, 1, 0); PG8_LDB(B1, 1, 1); PG8_SCHED; PG8_LDA(At, 1, 0); PG8_STAGE(PG8_SA(0, 1), a2 + hstep, voffA);
            PG8_WAIT_V(8); PG8_WAIT_L(0); PG8_BAR; PG8_MMA(0, 0, At, B0); PG8_MMA(0, 1, At, B1); PG8_BAR; PG8_SCHED;
            PG8_LDA(At, 1, 1); PG8_STAGE(PG8_SB(1, 0), b3, voffB); PG8_STAGE(PG8_SB(1, 1), b3 + hstep, voffB); PG8_STAGE(PG8_SA(1, 0), a3, voffA);
            PG8_WAIT_V(8); PG8_WAIT_L(0); PG8_BAR; PG8_MMA(1, 0, At, B0); PG8_MMA(1, 1, At, B1); PG8_BAR; PG8_SCHED;
            } else {
            PG8_LDB(B0, 0, 0); PG8_SCHED; PG8_LDA(At, 0, 0); PG8_STAGE(PG8_SA(1, 1), a1 + hstep, voffA);
            PG8_WAIT_L(8); PG8_BAR; PG8_WAIT_L(0); PG8_MMA(0, 0, At, B0); PG8_BAR; PG8_SCHED;
            PG8_LDB(B1, 0, 1); PG8_STAGE(PG8_SB(0, 0), b2, voffB);
            PG8_BAR; PG8_WAIT_L(0); PG8_MMA(0, 1, At, B1); PG8_BAR;
            PG8_LDA(At, 0, 1); PG8_STAGE(PG8_SA(0, 0), a2, voffA);
            PG8_BAR; PG8_WAIT_L(0); PG8_MMA(1, 0, At, B0); PG8_BAR; PG8_SCHED;
            PG8_STAGE(PG8_SB(0, 1), b2 + hstep, voffB);
            PG8_WAIT_V(6); PG8_BAR; PG8_MMA(1, 1, At, B1); PG8_BAR;
            PG8_LDB(B0, 1, 0); PG8_SCHED; PG8_LDA(At, 1, 0); PG8_STAGE(PG8_SA(0, 1), a2 + hstep, voffA);
            PG8_WAIT_L(8); PG8_BAR; PG8_WAIT_L(0); PG8_MMA(0, 0, At, B0); PG8_BAR; PG8_SCHED;
            PG8_LDB(B1, 1, 1); PG8_STAGE(PG8_SB(1, 0), b3, voffB);
            PG8_BAR; PG8_WAIT_L(0); PG8_MMA(0, 1, At, B1); PG8_BAR;
            PG8_LDA(At, 1, 1); PG8_STAGE(PG8_SA(1, 0), a3, voffA);
            PG8_BAR; PG8_WAIT_L(0); PG8_MMA(1, 0, At, B0); PG8_BAR; PG8_SCHED;
            PG8_STAGE(PG8_SB(1, 1), b3 + hstep, voffB);
            PG8_WAIT_V(6); PG8_BAR; PG8_MMA(1, 1, At, B1); PG8_BAR;
            }
        }
        if constexpr (ALIGN_EPI) { if (wr == 0) PG8_BAR; }
        if constexpr (!Epi::AFTER_DRAIN) { E(acc, cur, wr, wc, fr, fq); S.done(cur); }
        if (!has_next) break;
#pragma unroll
        for (int a = 0; a < 2; ++a)
#pragma unroll
            for (int b = 0; b < 2; ++b)
#pragma unroll
                for (int m = 0; m < 4; ++m)
#pragma unroll
                    for (int n = 0; n < 2; ++n) acc[a][b][m][n] = (f32x4){0.f, 0.f, 0.f, 0.f};
        cur = nxt; cA = nA; cB = nB; ++ui;
        if constexpr (ALIGN_EPI) { if (wr == 1) PG8_BAR; }
    }
    PG8_WAIT_V(0);
    if constexpr (!ALIGN_EPI) { if (wr == 0) PG8_BAR; }
    PG8_BAR;
    if constexpr (Epi::AFTER_DRAIN) { E.fused(acc, cur, wr, wc, fr, fq, lds, wid, lane); S.done(cur); }
#undef PG8_SA
#undef PG8_SB
#undef PG8_STAGE
#undef PG8_LDA
#undef PG8_LDB
#undef PG8_MMA
#undef PG8_WAIT_V
#undef PG8_WAIT_L
#undef PG8_BAR
#undef PG8_SCHED
}

template <int MODE>
DEV void side_gemm(const Params& p, const bf16_t* A, const bf16_t* Bt, int N, int K, char* smem) {
    const int tid = tid_(), wid = tid >> 6, lane = tid & 63, fr = lane & 15, fq = lane >> 4;
    f32x4* red = (f32x4*)smem;
    const int ntile = N / 16, G = gridDim.x, kw = K / 8;
    for (int j = G - 1 - (int)blockIdx.x; j < ntile; j += G) {
        const bf16_t* ap = A + (size_t)fr * K + wid * kw + 8 * fq;
        const bf16_t* bp = Bt + (size_t)(j * 16 + fr) * K + wid * kw + 8 * fq;
        f32x4 acc = {0.f, 0.f, 0.f, 0.f};
#pragma unroll 4
        for (int k = 0; k < kw; k += 32) {
            const bf16x8 a = *(const bf16x8*)(ap + k), b = *(const bf16x8*)(bp + k);
            acc = __builtin_amdgcn_mfma_f32_16x16x32_bf16(b, a, acc, 0, 0, 0);
        }
        red[wid * 64 + lane] = acc;
        __syncthreads();
        if (wid == 0) {
            f32x4 v = red[lane];
#pragma unroll
            for (int w = 1; w < 8; ++w) v += red[w * 64 + lane];
            const int row = MX + fr, col = j * 16 + 4 * fq;
            if (MODE == 0) {
                if (col < 512) v = v * QSCALE;
                uint2 w; w.x = pk_bf16(v[0], v[1]); w.y = pk_bf16(v[2], v[3]);
                *(uint2*)(p.u + (size_t)row * DIN + col) = w;
            } else if (MODE == 1) {
#pragma unroll
                for (int k = 0; k < 4; ++k) v[k] = fmaxf(v[k], 0.f);
                v = v * v;
                uint2 w; w.x = pk_bf16(v[0], v[1]); w.y = pk_bf16(v[2], v[3]);
                *(uint2*)(p.hid + (size_t)row * DFF + col) = w;
            } else {
                const uint2 hw = *(const uint2*)(p.hb + (size_t)row * D + col);
                f32x4 o;
                o[0] = ALPHA * bflo(hw.x) + v[0]; o[1] = ALPHA * bfhi(hw.x) + v[1]; o[2] = ALPHA * bflo(hw.y) + v[2]; o[3] = ALPHA * bfhi(hw.y) + v[3];
                *(f32x4*)(p.zmeta + (size_t)fr * D + col) = o;
            }
        }
        __syncthreads();
    }
}

template <int MODE>
DEV void gemm_run(const Params& p, const bf16_t* A, const bf16_t* Bt, int N, int K, char* smem) {
    Gemm g; g.A = A; g.Bt = Bt; g.M = MX; g.N = N; g.K = K;
    Order S; S.init(MX, N, gridDim.x, blockIdx.x);
    Epi<MODE> E; E.ob = MODE == 0 ? p.u : p.hid; E.hb = p.hb; E.zx = p.out; E.zm = p.zmeta;
    gemm_phase<Epi<MODE>, Order, true, true>((PG8_LAS unsigned char*)smem, g, S, E);
    __syncthreads();
    side_gemm<MODE>(p, A + (size_t)MX * K, Bt, N, K, smem);
}

DEV float softplus2(float z) {
    const float e = __builtin_amdgcn_exp2f(-fabsf(z));
    return fmaxf(z, 0.f) + __builtin_amdgcn_logf(1.0f + e);
}

constexpr int KS_STRIDE = 72;
constexpr int VT_STRIDE = 68;

constexpr int VT2_STRIDE = 36;
constexpr float EXIT_THRESH = 80.f;

DEV void attn_tile(const Params& p, int layer, int b, int p0, char* smem) {
    const int tid = tid_(), wid = tid >> 6, lane = tid & 63, ln = lane & 31, hh = lane >> 5;
    const int h = wid;
    bf16_t* Vt = (bf16_t*)smem + wid * (64 * VT2_STRIDE);
    float* ssq = (float*)(smem + 8 * 64 * VT2_STRIDE * 2);
    bf16x8 qf[4];
    {
        const bf16_t* qrow = p.u + (size_t)(b * SEQ + p0 + ln) * DIN + h * 64 + 8 * hh;
#pragma unroll
        for (int s = 0; s < 4; ++s) qf[s] = *(const bf16x8*)(qrow + 16 * s);
    }
    f32x16 o0 = {}, o1 = {};
    float c = 0.f;
    const int kp = lane & 15, dc = lane >> 4;
    uint4 kr[4], vr[4];
    auto load_sub = [&](int st) {
        int rk, rv0;
        if (st >= 0) { rk = b * SEQ + st * 32 + ln; rv0 = b * SEQ + st * 32 + 2 * kp; }
        else { rk = ln < NMETA ? row_of(b, ln) : -1; rv0 = 2 * kp < NMETA ? row_of(b, 2 * kp) : -1; }
        if (rk >= 0) {
            const bf16_t* kptr = p.u + (size_t)rk * DIN + 512 + h * 64 + 8 * hh;
#pragma unroll
            for (int s = 0; s < 4; ++s) kr[s] = *(const uint4*)(kptr + 16 * s);
        } else {
#pragma unroll
            for (int s = 0; s < 4; ++s) kr[s] = make_uint4(0, 0, 0, 0);
        }
        if (rv0 >= 0) {
            const bf16_t* vp = p.u + (size_t)rv0 * DIN + 1024 + h * 64 + 16 * dc;
            vr[0] = *(const uint4*)vp; vr[1] = *(const uint4*)(vp + 8); vr[2] = *(const uint4*)(vp + DIN); vr[3] = *(const uint4*)(vp + DIN + 8);
        } else {
#pragma unroll
            for (int s = 0; s < 4; ++s) vr[s] = make_uint4(0, 0, 0, 0);
        }
    };
    load_sub(p0 >> 5);
    for (int st = p0 >> 5; st >= -1; --st) {
        {
            unsigned* vt = (unsigned*)Vt + (16 * dc) * (VT2_STRIDE / 2) + kp;
            const unsigned a[8] = {vr[0].x, vr[0].y, vr[0].z, vr[0].w, vr[1].x, vr[1].y, vr[1].z, vr[1].w};
            const unsigned bq[8] = {vr[2].x, vr[2].y, vr[2].z, vr[2].w, vr[3].x, vr[3].y, vr[3].z, vr[3].w};
#pragma unroll
            for (int i = 0; i < 8; ++i) {
                vt[(2 * i) * (VT2_STRIDE / 2)] = (a[i] & 0xffffu) | (bq[i] << 16);
                vt[(2 * i + 1) * (VT2_STRIDE / 2)] = (a[i] >> 16) | (bq[i] & 0xffff0000u);
            }
        }
        union { uint4 u; bf16x8 v; } kf[4];
#pragma unroll
        for (int s = 0; s < 4; ++s) kf[s].u = kr[s];
        if (st > -1) load_sub(st - 1);
        __builtin_amdgcn_wave_barrier();
        f32x16 z = {};
#pragma unroll
        for (int s = 0; s < 4; ++s) z = __builtin_amdgcn_mfma_f32_32x32x16_bf16(kf[s].v, qf[s], z, 0, 0, 0);
        const bool masked = (st < 0) || (st * 32 == p0);
        const int lim = st < 0 ? NMETA : ln;
        float sp[16];
        if (masked) {
#pragma unroll
            for (int r = 0; r < 16; ++r) { const int kk = 8 * (r >> 2) + 4 * hh + (r & 3); sp[r] = kk < lim ? softplus2(z[r]) : 0.f; }
        } else {
#pragma unroll
            for (int r = 0; r < 16; ++r) sp[r] = softplus2(z[r]);
        }
        float G[4], PG[4];
#pragma unroll
        for (int j = 0; j < 4; ++j) { G[j] = (sp[4 * j] + sp[4 * j + 1]) + (sp[4 * j + 2] + sp[4 * j + 3]); PG[j] = __shfl_xor(G[j], 32); }
        float stt = 0.f, a[16];
#pragma unroll
        for (int j = 3; j >= 0; --j) {
            float run = stt + c + (hh == 0 ? PG[j] : 0.f);
#pragma unroll
            for (int i = 3; i >= 0; --i) {
                const int r = 4 * j + i;
                run += sp[r];
                a[r] = __builtin_amdgcn_exp2f(z[r] - run);
            }
            stt += G[j] + PG[j];
        }
        if (masked) {
#pragma unroll
            for (int r = 0; r < 16; ++r) { const int kk = 8 * (r >> 2) + 4 * hh + (r & 3); a[r] = kk < lim ? a[r] : 0.f; }
        }
        c += stt;
#pragma unroll
        for (int m = 0; m < 2; ++m) {
            union { bf16x8 v; unsigned w[4]; } af;
            af.w[0] = pk_bf16(a[8 * m + 0], a[8 * m + 1]); af.w[1] = pk_bf16(a[8 * m + 2], a[8 * m + 3]);
            af.w[2] = pk_bf16(a[8 * m + 4], a[8 * m + 5]); af.w[3] = pk_bf16(a[8 * m + 6], a[8 * m + 7]);
            union { bf16x8 v; uint2 d[2]; } v0, v1;
            const bf16_t* vb = Vt + ln * VT2_STRIDE + 16 * m + 4 * hh;
            v0.d[0] = *(const uint2*)vb; v0.d[1] = *(const uint2*)(vb + 8);
            v1.d[0] = *(const uint2*)(vb + 32 * VT2_STRIDE); v1.d[1] = *(const uint2*)(vb + 32 * VT2_STRIDE + 8);
            o0 = __builtin_amdgcn_mfma_f32_32x32x16_bf16(v0.v, af.v, o0, 0, 0, 0);
            o1 = __builtin_amdgcn_mfma_f32_32x32x16_bf16(v1.v, af.v, o1, 0, 0, 0);
        }
        __builtin_amdgcn_wave_barrier();
        if (__ballot(c < EXIT_THRESH) == 0) break;
    }
    {
        float ss = 0.f;
#pragma unroll
        for (int r = 0; r < 16; ++r) ss += o0[r] * o0[r] + o1[r] * o1[r];
        ss += __shfl_xor(ss, 32);
        if (hh == 0) ssq[wid * 32 + ln] = ss;
        __syncthreads();
        float tot = 0.f;
#pragma unroll
        for (int w = 0; w < 8; ++w) tot += ssq[w * 32 + ln];
        const float rn = rsqrtf(tot * (1.0f / 512.0f) + 1e-6f);
        const float* g = p.g_mix + (size_t)layer * D + h * 64 + 4 * hh;
        bf16_t* orow = p.y + (size_t)(b * SEQ + p0 + ln) * D + h * 64 + 4 * hh;
#pragma unroll
        for (int j = 0; j < 4; ++j) {
            const float4 g0 = *(const float4*)(g + 8 * j), g1 = *(const float4*)(g + 32 + 8 * j);
            uint2 w; w.x = pk_bf16(o0[4 * j] * rn * g0.x, o0[4 * j + 1] * rn * g0.y); w.y = pk_bf16(o0[4 * j + 2] * rn * g0.z, o0[4 * j + 3] * rn * g0.w);
            *(uint2*)(orow + 8 * j) = w;
            w.x = pk_bf16(o1[4 * j] * rn * g1.x, o1[4 * j + 1] * rn * g1.y); w.y = pk_bf16(o1[4 * j + 2] * rn * g1.z, o1[4 * j + 3] * rn * g1.w);
            *(uint2*)(orow + 32 + 8 * j) = w;
        }
    }
    __syncthreads();
}

DEV void attn_meta_unit(const Params& p, int h, char* smem) {
    float* qs = (float*)smem;
    float* ks = qs + 1024;
    float* vs = ks + 16 * 65;
    float* zs = vs + 1024;
    const int tid = tid_();
    for (int i = tid; i < 16 * 64; i += NTHREADS) {
        const int t = i >> 6, d = i & 63;
        const bf16_t* r = p.u + (size_t)(MX + t) * DIN + h * 64 + d;
        qs[t * 64 + d] = __uint_as_float((unsigned)r[0] << 16);
        ks[t * 65 + d] = __uint_as_float((unsigned)r[512] << 16);
        vs[t * 64 + d] = __uint_as_float((unsigned)r[1024] << 16);
    }
    __syncthreads();
    if (tid < 256) {
        const int t = tid >> 4, s = tid & 15;
        float acc = 0.f;
        for (int d = 0; d < 64; ++d) acc += qs[t * 64 + d] * ks[s * 65 + d];
        zs[tid] = acc;
    }
    __syncthreads();
    {
        const int t = tid >> 5, d0 = (tid & 31) * 2;
        float c = 0.f, oa = 0.f, ob = 0.f;
        for (int s = t - 1; s >= 0; --s) {
            const float z = zs[t * 16 + s];
            c += softplus2(z);
            const float a = __builtin_amdgcn_exp2f(z - c);
            oa += a * vs[s * 64 + d0]; ob += a * vs[s * 64 + d0 + 1];
        }
        *(unsigned*)(p.y + (size_t)(MX + t) * D + h * 64 + d0) = pk_bf16(oa, ob);
    }
    __syncthreads();
}

DEV float sigmoidf_(float v) { return 1.0f / (1.0f + __expf(-v)); }

DEV void post_unit(const Params& p, int layer, int b, int q0, int T, bool norm_attn, char* smem) {
    float* hc = (float*)smem;
    float* cv = hc + 62 * 256;
    const int tid = tid_(), wid = tid >> 6, lane = tid & 63;
    for (int i = tid; i < 62 * 32; i += NTHREADS) {
        const int r = i >> 5, c8 = (i & 31) * 8;
        const int q = q0 - 30 + r;
        float o[8];
        if (q >= 0 && r < T + 30) {
            const bf16_t* src = p.u + (size_t)row_of(b, q) * DIN + 1536 + c8;
            const uint4 a = *(const uint4*)src, g = *(const uint4*)(src + 256);
            o[0] = bflo(a.x) * sigmoidf_(bflo(g.x)); o[1] = bfhi(a.x) * sigmoidf_(bfhi(g.x));
            o[2] = bflo(a.y) * sigmoidf_(bflo(g.y)); o[3] = bfhi(a.y) * sigmoidf_(bfhi(g.y));
            o[4] = bflo(a.z) * sigmoidf_(bflo(g.z)); o[5] = bfhi(a.z) * sigmoidf_(bfhi(g.z));
            o[6] = bflo(a.w) * sigmoidf_(bflo(g.w)); o[7] = bfhi(a.w) * sigmoidf_(bfhi(g.w));
        } else {
#pragma unroll
            for (int k = 0; k < 8; ++k) o[k] = 0.f;
        }
        *(float4*)(hc + r * 256 + c8) = make_float4(o[0], o[1], o[2], o[3]);
        *(float4*)(hc + r * 256 + c8 + 4) = make_float4(o[4], o[5], o[6], o[7]);
    }
    __syncthreads();
    {
        const int ch = tid & 255, half = tid >> 8;
        const float* wdw = p.w_conf_dw + (size_t)layer * 31 * 256 + ch;
        float w[31];
#pragma unroll
        for (int k = 0; k < 31; ++k) w[k] = wdw[k * 256];
        const float bias = p.b_conf_dw[layer * 256 + ch];
        float acc[16];
#pragma unroll
        for (int i = 0; i < 16; ++i) acc[i] = bias;
        const float* src = hc + (half * 16) * 256 + ch;
#pragma unroll
        for (int j = 0; j < 46; ++j) {
            const float v = src[j * 256];
#pragma unroll
            for (int i = 0; i < 16; ++i) if (j - i >= 0 && j - i <= 30) acc[i] += w[j - i] * v;
        }
#pragma unroll
        for (int i = 0; i < 16; ++i) cv[(half * 16 + i) * 256 + ch] = acc[i];
    }
    __syncthreads();
    const float* gmix = p.g_mix + (size_t)layer * D;
    for (int i = wid; i < T; i += 8) {
        const int q = q0 + i, row = row_of(b, q);
        bf16_t* yrow = p.y + (size_t)row * D;
        {
            const int c0 = lane * 4;
            const float4 v = *(const float4*)(cv + i * 256 + c0);
            const float mu = wave_sum((v.x + v.y) + (v.z + v.w)) * (1.0f / 256.0f);
            const float dx = v.x - mu, dy = v.y - mu, dz = v.z - mu, dw = v.w - mu;
            const float rstd = rsqrtf(wave_sum((dx * dx + dy * dy) + (dz * dz + dw * dw)) * (1.0f / 256.0f) + 1e-5f);
            const float4 g = *(const float4*)(p.ln_conf_g + layer * 256 + c0), bb = *(const float4*)(p.ln_conf_b + layer * 256 + c0);
            float t0 = dx * rstd * g.x + bb.x, t1 = dy * rstd * g.y + bb.y, t2 = dz * rstd * g.z + bb.z, t3 = dw * rstd * g.w + bb.w;
            t0 *= sigmoidf_(t0); t1 *= sigmoidf_(t1); t2 *= sigmoidf_(t2); t3 *= sigmoidf_(t3);
            const float r = rsqrtf(wave_sum((t0 * t0 + t1 * t1) + (t2 * t2 + t3 * t3)) * (1.0f / 256.0f) + 1e-6f);
            const float4 gm = *(const float4*)(gmix + 512 + c0);
            uint2 w; w.x = pk_bf16(t0 * r * gm.x, t1 * r * gm.y); w.y = pk_bf16(t2 * r * gm.z, t3 * r * gm.w);
            *(uint2*)(yrow + 512 + c0) = w;
        }
        {
            const int c0 = lane * 4;
            float s0 = 0.f, s1 = 0.f, s2 = 0.f, s3 = 0.f;
#pragma unroll
            for (int k = 0; k < 3; ++k) {
                const int qq = q - 2 + k;
                if (qq >= 0) {
                    const bf16_t* src = p.u + (size_t)row_of(b, qq) * DIN + 2304 + c0;
                    const uint2 cg_ = *(const uint2*)src, hv = *(const uint2*)(src + 256);
                    const float4 wk = *(const float4*)(p.w_short_dw + (size_t)layer * 3 * 256 + k * 256 + c0);
                    s0 += wk.x * bflo(cg_.x) * bflo(hv.x); s1 += wk.y * bfhi(cg_.x) * bfhi(hv.x);
                    s2 += wk.z * bflo(cg_.y) * bflo(hv.y); s3 += wk.w * bfhi(cg_.y) * bfhi(hv.y);
                }
            }
            const uint2 bg = *(const uint2*)(p.u + (size_t)row * DIN + 2048 + c0);
            s0 *= bflo(bg.x); s1 *= bfhi(bg.x); s2 *= bflo(bg.y); s3 *= bfhi(bg.y);
            const float r = rsqrtf(wave_sum((s0 * s0 + s1 * s1) + (s2 * s2 + s3 * s3)) * (1.0f / 256.0f) + 1e-6f);
            const float4 gm = *(const float4*)(gmix + 768 + c0);
            uint2 w; w.x = pk_bf16(s0 * r * gm.x, s1 * r * gm.y); w.y = pk_bf16(s2 * r * gm.z, s3 * r * gm.w);
            *(uint2*)(yrow + 768 + c0) = w;
        }
        if (norm_attn) {
            const int c0 = lane * 8;
            const uint4 ov = *(const uint4*)(yrow + c0);
            float f[8] = {bflo(ov.x), bfhi(ov.x), bflo(ov.y), bfhi(ov.y), bflo(ov.z), bfhi(ov.z), bflo(ov.w), bfhi(ov.w)};
            float ss = 0.f;
#pragma unroll
            for (int k = 0; k < 8; ++k) ss += f[k] * f[k];
            const float r = rsqrtf(wave_sum(ss) * (1.0f / 512.0f) + 1e-6f);
            const float4 g0 = *(const float4*)(gmix + c0), g1 = *(const float4*)(gmix + c0 + 4);
            uint4 w;
            w.x = pk_bf16(f[0] * r * g0.x, f[1] * r * g0.y); w.y = pk_bf16(f[2] * r * g0.z, f[3] * r * g0.w);
            w.z = pk_bf16(f[4] * r * g1.x, f[5] * r * g1.y); w.w = pk_bf16(f[6] * r * g1.z, f[7] * r * g1.w);
            *(uint4*)(yrow + c0) = w;
        }
    }
    __syncthreads();
}

DEV void mixer_phase(const Params& p, int layer, char* smem) {
    const int nx = NB * (SEQ / 32), ntot = nx + 1;
    for (int u = blockIdx.x; u < ntot; u += gridDim.x) {
        if (u < nx) {
            const int b = u / (SEQ / 32), p0 = (u % (SEQ / 32)) * 32;
            attn_tile(p, layer, b, p0, smem);
            post_unit(p, layer, b, NMETA + p0, 32, false, smem);
        } else {
            for (int h = 0; h < 8; ++h) attn_meta_unit(p, h, smem);
            post_unit(p, layer, 0, 0, NMETA, true, smem);
        }
    }
}

constexpr int NPHASE = 1 + DEPTH * 7;

DEV void run_phase(const Params& p, int ph, char* smem) {
#ifdef TESTP
    const int l = (ph - 1) / 7, s = TESTP;
    if (TESTP == 8) { prologue_phase(p, smem); return; }
#else
    if (ph == 0) { prologue_phase(p, smem); return; }
    const int l = (ph - 1) / 7, s = (ph - 1) % 7;
#endif
    switch (s) {
        case 0: gemm_run<0>(p, p.hb, p.wt_in + (size_t)l * D * DIN, DIN, D, smem); break;
        case 1: mixer_phase(p, l, smem); break;
        case 2: gemm_run<2>(p, p.y, p.wt_out + (size_t)l * D * D, D, D, smem); break;
        case 3: ln_phase(p, p.ln_mix_g + l * D, p.ln_mix_b + l * D, false); break;
        case 4: gemm_run<1>(p, p.hb, p.wt_ff1 + (size_t)l * D * DFF, DFF, D, smem); break;
        case 5: gemm_run<2>(p, p.hid, p.wt_ff2 + (size_t)l * D * DFF, D, DFF, smem); break;
        default: ln_phase(p, p.ln_ff_g + l * D, p.ln_ff_b + l * D, l == DEPTH - 1); break;
    }
}

__global__ void __launch_bounds__(NTHREADS, 2) mega(Params p, int ph_begin, int ph_end) {
    extern __shared__ __attribute__((aligned(16))) char smem[];
    cg::grid_group grid = cg::this_grid();
    for (int ph = ph_begin; ph < ph_end; ++ph) {
        run_phase(p, ph, smem);
#ifdef PROBE_DUP
        if (ph > 0 && (ph - 1) % 7 == PROBE_DUP) { grid.sync(); run_phase(p, ph, smem); }
#endif
        if (ph + 1 < ph_end) grid.sync();
    }
}

extern "C" void kernel_launch(void* const* d_in, const int* in_sizes, int n_in, void* d_out, int out_size, void* d_ws, size_t ws_size,
                              hipStream_t stream) {
    static int grid_blocks = 0;
    if (!grid_blocks) {
        int dev = 0, cus = 0, per_cu = 0;
        hipGetDevice(&dev);
        hipDeviceGetAttribute(&cus, hipDeviceAttributeMultiprocessorCount, dev);
        hipFuncSetAttribute((const void*)mega, hipFuncAttributeMaxDynamicSharedMemorySize, LDS_BYTES);
        hipOccupancyMaxActiveBlocksPerMultiprocessor(&per_cu, mega, NTHREADS, LDS_BYTES);
        if (per_cu < 1) per_cu = 1;
        grid_blocks = cus * (per_cu > 1 ? 1 : per_cu);
    }
    Params p{};
    const float* const* in = (const float* const*)d_in;
    p.x = in[0]; p.meta = in[1]; p.ln_in_g = in[2]; p.ln_in_b = in[3]; p.w_in = in[4]; p.w_conf_dw = in[5]; p.b_conf_dw = in[6];
    p.ln_conf_g = in[7]; p.ln_conf_b = in[8]; p.w_short_dw = in[9]; p.g_mix = in[10]; p.w_out = in[11]; p.ln_mix_g = in[12];
    p.ln_mix_b = in[13]; p.w_ff1 = in[14]; p.w_ff2 = in[15]; p.ln_ff_g = in[16]; p.ln_ff_b = in[17];
    p.out = (float*)d_out;
    char* ws = (char*)d_ws;
    size_t off = 0;
    auto take = [&](size_t bytes) { char* r = ws + off; off += (bytes + 255) & ~(size_t)255; return r; };
    p.wt_in = (bf16_t*)take((size_t)DEPTH * D * DIN * 2);
    p.wt_out = (bf16_t*)take((size_t)DEPTH * D * D * 2);
    p.wt_ff1 = (bf16_t*)take((size_t)DEPTH * D * DFF * 2);
    p.wt_ff2 = (bf16_t*)take((size_t)DEPTH * D * DFF * 2);
    p.hb = (bf16_t*)take((size_t)MTOT * D * 2);
    p.zmeta = (float*)take((size_t)NMETA * D * 4);
    p.hid = (bf16_t*)take((size_t)MTOT * DFF * 2);
    p.u = p.hid;
    p.y = p.hid + (size_t)MTOT * DIN;
    if (off > ws_size) { fprintf(stderr, "workspace too small: need %zu have %zu\n", off, ws_size); return; }
#if ONE_LAUNCH
    int b = 0, e = NPHASE;
    void* args[] = {&p, &b, &e};
    hipError_t err = hipLaunchCooperativeKernel((const void*)mega, dim3(grid_blocks), dim3(NTHREADS), args, LDS_BYTES, stream);
    if (err != hipSuccess) fprintf(stderr, "cooperative launch failed: %s (grid %d)\n", hipGetErrorString(err), grid_blocks);
#else
    for (int ph = 0; ph < NPHASE; ++ph) {
        int b = ph, e = ph + 1;
        void* args[] = {&p, &b, &e};
        hipError_t err = hipLaunchCooperativeKernel((const void*)mega, dim3(grid_blocks), dim3(NTHREADS), args, LDS_BYTES, stream);
        if (err != hipSuccess) fprintf(stderr, "launch failed: %s\n", hipGetErrorString(err));
    }
#endif
}
```
